# Optimizing an MI355X kernel written in HIP

```python
import jax, jax.numpy as jnp
from jax import lax
import numpy as np

D_MODEL = 1024
BATCH = 2
SEQ = 8192
DEPTH = 2

D_FF = 2816
CONV_WIDTH = 512
CONV_K = 31
SGU_WIDTH = 512
SGU_GROUPS = 4
SGU_CHUNK = 128
ATT_HEADS = 8
HEAD_DIM = 64
ATT_WIDTH = ATT_HEADS * HEAD_DIM
MOBA_BLOCK = 256
MOBA_TOPK = 3
Q_CHUNK = 64
ROPE_THETA = 500000.0
ROPE_DIM = HEAD_DIM // 4
N_BRANCH = 3
EPS = 1e-6
N_IN = 2 * CONV_WIDTH + 2 * SGU_WIDTH + 3 * ATT_WIDTH + N_BRANCH * D_MODEL

kernel_name = "hybrid_gated_conv_gmlp_moba_macaron"


def _rmsnorm(x, g):
    xf = x.astype(jnp.float32)
    y = xf * lax.rsqrt(jnp.mean(xf * xf, axis=-1, keepdims=True) + EPS)
    return (y * g.astype(jnp.float32)).astype(x.dtype)


def _layernorm(x, g, b):
    xf = x.astype(jnp.float32)
    mu = jnp.mean(xf, axis=-1, keepdims=True)
    var = jnp.mean(jnp.square(xf - mu), axis=-1, keepdims=True)
    y = (xf - mu) * lax.rsqrt(var + EPS)
    return (y * g.astype(jnp.float32) + b.astype(jnp.float32)).astype(x.dtype)


def _swiglu(x, wi, wo):
    gate, up = jnp.split(x @ wi, 2, axis=-1)
    return (jax.nn.silu(gate) * up) @ wo


def _rope_tables(seq):
    pos = jnp.arange(seq, dtype=jnp.float32)
    inv_freq = ROPE_THETA ** (-jnp.arange(0, ROPE_DIM, 2, dtype=jnp.float32) / ROPE_DIM)
    ang = pos[:, None] * inv_freq[None, :]
    return jnp.cos(ang), jnp.sin(ang)


def _partial_rope(x, cos, sin):
    c = cos[None, :, None, :].astype(x.dtype)
    s = sin[None, :, None, :].astype(x.dtype)
    half = ROPE_DIM // 2
    x1 = x[..., :half]
    x2 = x[..., half:ROPE_DIM]
    return jnp.concatenate([x1 * c - x2 * s, x2 * c + x1 * s, x[..., ROPE_DIM:]], axis=-1)


def _conv_module(z, conv_w, conv_b, ln_g, ln_b):
    a, g = jnp.split(z, 2, axis=-1)
    y = a * jax.nn.sigmoid(g)
    y = lax.conv_general_dilated(
        y, conv_w[:, None, :], window_strides=(1,),
        padding=[(CONV_K - 1, 0)],
        dimension_numbers=("NWC", "WIO", "NWC"),
        feature_group_count=CONV_WIDTH) + conv_b
    y = _layernorm(y, ln_g, ln_b)
    return jax.nn.silu(y)


def _sgu_module(z, ln_g, ln_b, w_s, b_s):
    u, v = jnp.split(jax.nn.gelu(z), 2, axis=-1)
    v = _layernorm(v, ln_g, ln_b)
    bsz, seq, _ = v.shape
    vc = v.reshape(bsz, seq // SGU_CHUNK, SGU_CHUNK, SGU_GROUPS, SGU_WIDTH // SGU_GROUPS)
    causal = jnp.tril(jnp.ones((SGU_CHUNK, SGU_CHUNK), dtype=bool))
    w = jnp.where(causal[None], w_s, 0.0)
    mixed = jnp.einsum("gts,bnsgc->bntgc", w, vc) + b_s.T[None, None, :, :, None]
    return u * mixed.reshape(bsz, seq, SGU_WIDTH)


def _moba_attention(q, k, v):
    bsz, seq, nh, dh = q.shape
    s_pad = -(-seq // MOBA_BLOCK) * MOBA_BLOCK
    pad = [(0, 0), (0, s_pad - seq), (0, 0), (0, 0)]
    qh = jnp.pad(q, pad).transpose(0, 2, 1, 3)
    kh = jnp.pad(k, pad).transpose(0, 2, 1, 3)
    vh = jnp.pad(v, pad).transpose(0, 2, 1, 3)
    nb = s_pad // MOBA_BLOCK
    kb = kh.reshape(bsz, nh, nb, MOBA_BLOCK, dh)
    vb = vh.reshape(bsz, nh, nb, MOBA_BLOCK, dh)

    kmean = jnp.mean(kb.astype(jnp.float32), axis=3).astype(q.dtype)
    gate = jnp.einsum("bhsd,bhnd->bhsn", qh, kmean).astype(jnp.float32)
    qblk = jnp.arange(s_pad) // MOBA_BLOCK
    past = jnp.arange(nb)[None, :] < qblk[:, None]
    gate = jnp.where(past[None, None], gate, -jnp.inf)
    k_top = min(MOBA_TOPK, nb)
    _, sel = lax.top_k(gate, k_top)
    sel_valid = sel < qblk[None, None, :, None]
    own = jnp.broadcast_to(qblk[None, None, :, None], (bsz, nh, s_pad, 1))
    idx = jnp.concatenate([sel, own.astype(sel.dtype)], axis=-1)
    n_sel = k_top + 1

    n_chunks = s_pad // Q_CHUNK
    q_c = qh.reshape(bsz, nh, n_chunks, Q_CHUNK, dh).transpose(2, 0, 1, 3, 4)
    idx_c = idx.reshape(bsz, nh, n_chunks, Q_CHUNK, n_sel).transpose(2, 0, 1, 3, 4)
    val_c = sel_valid.reshape(bsz, nh, n_chunks, Q_CHUNK, k_top).transpose(2, 0, 1, 3, 4)
    bi = jnp.arange(bsz)[:, None, None, None]
    hi = jnp.arange(nh)[None, :, None, None]
    key_off = jnp.arange(MOBA_BLOCK)
    scale = HEAD_DIM ** -0.5

    def step(args):
        qc, ic, vc, c = args
        kg = kb[bi, hi, ic]
        vg = vb[bi, hi, ic]
        s = jnp.einsum("bhqd,bhqnkd->bhqnk", qc, kg).astype(jnp.float32) * scale
        qpos = c * Q_CHUNK + jnp.arange(Q_CHUNK)
        own_kpos = ic[..., -1:, None] * MOBA_BLOCK + key_off
        own_mask = own_kpos <= qpos[None, None, :, None, None]
        sel_mask = jnp.broadcast_to(vc[..., None], (bsz, nh, Q_CHUNK, k_top, MOBA_BLOCK))
        mask = jnp.concatenate([sel_mask, own_mask], axis=3)
        s = jnp.where(mask, s, -jnp.inf)
        p = jax.nn.softmax(s.reshape(bsz, nh, Q_CHUNK, n_sel * MOBA_BLOCK), axis=-1)
        p = p.reshape(bsz, nh, Q_CHUNK, n_sel, MOBA_BLOCK).astype(vg.dtype)
        return jnp.einsum("bhqnk,bhqnkd->bhqd", p, vg)

    out = lax.map(step, (q_c, idx_c, val_c, jnp.arange(n_chunks)))
    out = out.transpose(1, 0, 3, 2, 4).reshape(bsz, s_pad, nh * dh)
    return out[:, :seq]


def _layer(x, cos, sin, ffn1_norm, ffn1_wi, ffn1_wo, mix_norm, w_in, conv_w, conv_b,
           conv_ln_g, conv_ln_b, sgu_ln_g, sgu_ln_b, sgu_w, sgu_b, w_branch, gate_b,
           w_out, ffn2_norm, ffn2_wi, ffn2_wo):
    bsz, seq, _ = x.shape
    x = x + 0.5 * _swiglu(_rmsnorm(x, ffn1_norm), ffn1_wi, ffn1_wo)

    h = _rmsnorm(x, mix_norm)
    z = h @ w_in
    splits = list(np.cumsum([2 * CONV_WIDTH, 2 * SGU_WIDTH, ATT_WIDTH, ATT_WIDTH, ATT_WIDTH]))
    z_conv, z_sgu, z_q, z_k, z_v, z_gate = jnp.split(z, splits, axis=-1)

    y_a = _conv_module(z_conv, conv_w, conv_b, conv_ln_g, conv_ln_b)
    y_b = _sgu_module(z_sgu, sgu_ln_g, sgu_ln_b, sgu_w, sgu_b)
    q = _partial_rope(z_q.reshape(bsz, seq, ATT_HEADS, HEAD_DIM), cos, sin)
    k = _partial_rope(z_k.reshape(bsz, seq, ATT_HEADS, HEAD_DIM), cos, sin)
    v = z_v.reshape(bsz, seq, ATT_HEADS, HEAD_DIM)
    y_c = _moba_attention(q, k, v)

    branches = jnp.stack([y_a, y_b, y_c], axis=2)
    proj = jnp.einsum("bsnc,ncd->bsnd", branches, w_branch)
    gates = jax.nn.sigmoid(z_gate.reshape(bsz, seq, N_BRANCH, D_MODEL) + gate_b)
    merged = jnp.sum(gates * proj, axis=2)
    x = x + merged @ w_out

    x = x + 0.5 * _swiglu(_rmsnorm(x, ffn2_norm), ffn2_wi, ffn2_wo)
    return x


def setup_inputs(seed: int = 0) -> dict:
    key = jax.random.key(seed)
    ks = jax.random.split(key, 24)
    L, D = DEPTH, D_MODEL

    def nrm(k, shape, scale):
        return jax.random.normal(k, shape, jnp.float32) * scale

    return {
        "x": nrm(ks[0], (BATCH, SEQ, D), 1.0),
        "ffn1_norm": 1.0 + nrm(ks[1], (L, D), 0.01),
        "ffn1_wi": nrm(ks[2], (L, D, 2 * D_FF), D ** -0.5),
        "ffn1_wo": nrm(ks[3], (L, D_FF, D), D_FF ** -0.5),
        "mix_norm": 1.0 + nrm(ks[4], (L, D), 0.01),
        "w_in": nrm(ks[5], (L, D, N_IN), D ** -0.5),
        "conv_w": nrm(ks[6], (L, CONV_K, CONV_WIDTH), CONV_K ** -0.5),
        "conv_b": nrm(ks[7], (L, CONV_WIDTH), 0.01),
        "conv_ln_g": 1.0 + nrm(ks[8], (L, CONV_WIDTH), 0.01),
        "conv_ln_b": nrm(ks[9], (L, CONV_WIDTH), 0.01),
        "sgu_ln_g": 1.0 + nrm(ks[10], (L, SGU_WIDTH), 0.01),
        "sgu_ln_b": nrm(ks[11], (L, SGU_WIDTH), 0.01),
        "sgu_w": nrm(ks[12], (L, SGU_GROUPS, SGU_CHUNK, SGU_CHUNK), SGU_CHUNK ** -0.5),
        "sgu_b": 1.0 + nrm(ks[13], (L, SGU_GROUPS, SGU_CHUNK), 0.01),
        "w_branch": nrm(ks[14], (L, N_BRANCH, CONV_WIDTH, D), CONV_WIDTH ** -0.5),
        "gate_b": nrm(ks[15], (L, N_BRANCH, D), 0.01),
        "w_out": nrm(ks[16], (L, D, D), D ** -0.5),
        "ffn2_norm": 1.0 + nrm(ks[17], (L, D), 0.01),
        "ffn2_wi": nrm(ks[18], (L, D, 2 * D_FF), D ** -0.5),
        "ffn2_wo": nrm(ks[19], (L, D_FF, D), D_FF ** -0.5),
        "final_norm": 1.0 + nrm(ks[20], (D,), 0.01),
    }


def reference(x, ffn1_norm, ffn1_wi, ffn1_wo, mix_norm, w_in, conv_w, conv_b, conv_ln_g,
              conv_ln_b, sgu_ln_g, sgu_ln_b, sgu_w, sgu_b, w_branch, gate_b, w_out,
              ffn2_norm, ffn2_wi, ffn2_wo, final_norm):
    cos, sin = _rope_tables(x.shape[1])
    for l in range(DEPTH):
        x = _layer(x, cos, sin, ffn1_norm[l], ffn1_wi[l], ffn1_wo[l], mix_norm[l], w_in[l],
                   conv_w[l], conv_b[l], conv_ln_g[l], conv_ln_b[l], sgu_ln_g[l],
                   sgu_ln_b[l], sgu_w[l], sgu_b[l], w_branch[l], gate_b[l], w_out[l],
                   ffn2_norm[l], ffn2_wi[l], ffn2_wo[l])
    return _rmsnorm(x, final_norm)
```

```cpp
#include <hip/hip_runtime.h>
#include <hip/hip_cooperative_groups.h>
#include <hip/hip_bf16.h>
#include <cstdio>
#include <cstdint>
#include <cmath>
namespace cg = cooperative_groups;
namespace pg8 {
#define PG8_LAS __attribute__((address_space(3)))
typedef unsigned short bf16_t;
typedef short bf16x8 __attribute__((ext_vector_type(8)));
typedef float f32x4 __attribute__((ext_vector_type(4)));
typedef unsigned u32x4 __attribute__((ext_vector_type(4)));
constexpr int BM = 256, BK = 64, HALF = 128, HTB = HALF * BK * 2  , STAGE_BYTES = 8 * HTB, NXCD = 8, WGM = 8;

__host__ __device__ __forceinline__ int lds_byte(int r, int c) { const int st = (r >> 4) * 2 + (c >> 5), rr = r & 15, cc = c & 31, ob = rr * 64 + cc * 2; return st * 1024 + (ob ^ (((ob >> 9) & 1) << 5)); }
__host__ __device__ __forceinline__ void stage_rc(int b, int& R, int& C) { const int st = b / 1024, sb = b % 1024, swz = sb ^ (((sb >> 9) & 1) << 5); R = (st >> 1) * 16 + swz / 64; C = (st & 1) * 32 + (swz % 64) / 2; }
__host__ __device__ __forceinline__ int perm32(int rho) { const int n = rho >> 4, i = rho & 15; return 8 * (i >> 2) + 4 * n + (i & 3); }

struct Unit { int pm, pn; };
struct Gemm { const bf16_t* A; const bf16_t* Bt; int M, N, K; };

struct StaticOrder {
    int nM, nN, nwg, G, c;
    __host__ __device__ void init(int M, int N, int G_, int c_) { nM = M / BM; nN = N / BM; nwg = nM * nN; G = G_; c = c_; }
    __host__ __device__ bool next(int i, Unit& u) const {
        const long L = (long)i * G + c; if (L >= nwg) return false;
        int wgid = (int)L; { const int q = nwg / NXCD, r = nwg % NXCD, xcd = wgid % NXCD, off = wgid / NXCD; wgid = (xcd < r ? xcd * (q + 1) : r * (q + 1) + (xcd - r) * q) + off; }
        const int nig = WGM * nN, gid = wgid / nig, fm = gid * WGM, gsz = (nM - fm) < WGM ? (nM - fm) : WGM;
        u.pm = fm + ((wgid % nig) % gsz); u.pn = (wgid % nig) / gsz; return true;
    }
    __device__ __forceinline__ void a_ready(const Unit&) const {}
    __device__ __forceinline__ void done(const Unit&) const {}
};

__device__ __forceinline__ unsigned cvt_pk_bf16(float lo, float hi) { unsigned r; asm volatile("v_cvt_pk_bf16_f32 %0, %1, %2" : "=v"(r) : "v"(lo), "v"(hi)); return r; }
typedef float f32x2 __attribute__((ext_vector_type(2)));
template <class Epi, class Sched, bool ALIGN_EPI = false, bool SP2 = false>
__device__ __forceinline__ void gemm_phase(PG8_LAS unsigned char* lds, const Gemm g, const Sched& S, const Epi& E) {
    int tid_ = threadIdx.x; asm volatile("" : "+v"(tid_));
    const int tid = tid_, wid = __builtin_amdgcn_readfirstlane(tid >> 6), lane = tid & 63, wr = wid >> 2, wc = wid & 3, fr = lane & 15, fq = lane >> 4;
    const int K = g.K, nt = K / BK;
    unsigned voffA[2], voffB[2];
#pragma unroll
    for (int i = 0; i < 2; ++i) { int R, C; stage_rc(tid * 16 + i * 8192, R, C); const int Rb = Epi::PERM ? ((R & ~31) + perm32(R & 31)) : R;
        voffA[i] = (unsigned)(R * K + C) * 2u; voffB[i] = (unsigned)(Rb * K + C) * 2u; }
    const size_t kstep = (size_t)(BK * 2);
    const size_t hstep = (size_t)HALF * K * 2;
    const size_t tstep = 2 * hstep;
    const unsigned ldsw = (unsigned)wid * 1024u;
    const int aoff = lds_byte(wr * 64 + fr, fq * 8), boff = lds_byte(wc * 32 + fr, fq * 8);
#define PG8_SA(b, h) (((b) * 2 + (h)) * HTB)
#define PG8_SB(b, h) ((4 + (b) * 2 + (h)) * HTB)
#define PG8_STAGE(bufoff, gbase, voff) do { _Pragma("unroll") for (int _i = 0; _i < 2; ++_i) \
        __builtin_amdgcn_global_load_lds((const unsigned*)((const char*)(gbase) + (voff)[_i]), (PG8_LAS unsigned*)(lds + (bufoff) + ldsw + _i * 8192), 16, 0, 0); } while (0)
#define PG8_LDA(dst, b, h) do { _Pragma("unroll") for (int m = 0; m < 4; ++m) _Pragma("unroll") for (int k = 0; k < 2; ++k) dst[m][k] = *(const PG8_LAS bf16x8*)(lds + PG8_SA(b, h) + aoff + m * 2048 + k * 1024); } while (0)
#define PG8_LDB(dst, b, h) do { _Pragma("unroll") for (int n = 0; n < 2; ++n) _Pragma("unroll") for (int k = 0; k < 2; ++k) dst[n][k] = *(const PG8_LAS bf16x8*)(lds + PG8_SB(b, h) + boff + n * 2048 + k * 1024); } while (0)
#define PG8_MMA(ai, bj, At, Bt) do { __builtin_amdgcn_s_setprio(1); _Pragma("unroll") for (int m = 0; m < 4; ++m) _Pragma("unroll") for (int n = 0; n < 2; ++n) _Pragma("unroll") for (int k = 0; k < 2; ++k) \
        acc[ai][bj][m][n] = __builtin_amdgcn_mfma_f32_16x16x32_bf16(Bt[n][k], At[m][k], acc[ai][bj][m][n], 0, 0, 0); __builtin_amdgcn_s_setprio(0); } while (0)
#define PG8_WAIT_V(n) asm volatile("s_waitcnt vmcnt(" #n ")" ::: "memory")
#define PG8_WAIT_L(n) asm volatile("s_waitcnt lgkmcnt(" #n ")" ::: "memory")
#define PG8_BAR __builtin_amdgcn_s_barrier()
#define PG8_SCHED __builtin_amdgcn_sched_barrier(0)
    Unit cur, nxt; int ui = 0;
    if (!S.next(0, cur)) return;
    f32x4 acc[2][2][4][2];
#pragma unroll
    for (int a = 0; a < 2; ++a)
#pragma unroll
        for (int b = 0; b < 2; ++b)
#pragma unroll
            for (int m = 0; m < 4; ++m)
#pragma unroll
                for (int n = 0; n < 2; ++n) acc[a][b][m][n] = (f32x4){0.f, 0.f, 0.f, 0.f};
    bf16x8 At[4][2], B0[2][2], B1[2][2];
    const char* cA = (const char*)g.A + (size_t)cur.pm * tstep; const char* cB = (const char*)g.Bt + (size_t)cur.pn * tstep;
    S.a_ready(cur);
    if constexpr (SP2) {
        PG8_STAGE(PG8_SB(0, 0), cB, voffB); PG8_STAGE(PG8_SB(0, 1), cB + hstep, voffB); PG8_STAGE(PG8_SA(0, 0), cA, voffA); PG8_STAGE(PG8_SA(0, 1), cA + hstep, voffA);
        if (wr == 1) PG8_BAR;
        PG8_WAIT_V(2); PG8_BAR;
        PG8_STAGE(PG8_SB(1, 0), cB + kstep, voffB); PG8_STAGE(PG8_SA(1, 0), cA + kstep, voffA); PG8_STAGE(PG8_SB(1, 1), cB + hstep + kstep, voffB);
        PG8_WAIT_V(6); PG8_BAR;
    } else {
        PG8_STAGE(PG8_SB(0, 0), cB, voffB); PG8_STAGE(PG8_SA(0, 0), cA, voffA); PG8_STAGE(PG8_SB(0, 1), cB + hstep, voffB); PG8_STAGE(PG8_SA(0, 1), cA + hstep, voffA);
        if (wr == 1) PG8_BAR;
        PG8_WAIT_V(4); PG8_BAR;
        PG8_STAGE(PG8_SB(1, 0), cB + kstep, voffB); PG8_STAGE(PG8_SA(1, 0), cA + kstep, voffA); PG8_STAGE(PG8_SB(1, 1), cB + hstep + kstep, voffB);
        PG8_WAIT_V(6); PG8_BAR;
    }
    for (;;) {
        const bool has_next = S.next(ui + 1, nxt);
        const char* nA = has_next ? (const char*)g.A + (size_t)nxt.pm * tstep : cA; const char* nB = has_next ? (const char*)g.Bt + (size_t)nxt.pn * tstep : cB;
        for (int t = 0; t < nt; t += 2) {
            const bool last = (t == nt - 2);
            const char* a1 = cA + (size_t)(t + 1) * kstep;
            const char* a2 = last ? nA : cA + (size_t)(t + 2) * kstep; const char* b2 = last ? nB : cB + (size_t)(t + 2) * kstep;
            const char* a3 = a2 + kstep; const char* b3 = b2 + kstep;
            if (last && has_next) S.a_ready(nxt);
            if constexpr (SP2) {
            PG8_LDB(B0, 0, 0); PG8_LDB(B1, 0, 1); PG8_SCHED; PG8_LDA(At, 0, 0); PG8_STAGE(PG8_SA(1, 1), a1 + hstep, voffA);
            PG8_WAIT_V(8); PG8_WAIT_L(0); PG8_BAR; PG8_MMA(0, 0, At, B0); PG8_MMA(0, 1, At, B1); PG8_BAR; PG8_SCHED;
            PG8_LDA(At, 0, 1); PG8_STAGE(PG8_SB(0, 0), b2, voffB); PG8_STAGE(PG8_SB(0, 1), b2 + hstep, voffB); PG8_STAGE(PG8_SA(0, 0), a2, voffA);
            PG8_WAIT_V(8); PG8_WAIT_L(0); PG8_BAR; PG8_MMA(1, 0, At, B0); PG8_MMA(1, 1, At, B1); PG8_BAR; PG8_SCHED;
            PG8_LDB(B0, 1, 0); PG8_LDB(B1, 1, 1); PG8_SCHED; PG8_LDA(At, 1, 0); PG8_STAGE(PG8_SA(0, 1), a2 + hstep, voffA);
            PG8_WAIT_V(8); PG8_WAIT_L(0); PG8_BAR; PG8_MMA(0, 0, At, B0); PG8_MMA(0, 1, At, B1); PG8_BAR; PG8_SCHED;
            PG8_LDA(At, 1, 1); PG8_STAGE(PG8_SB(1, 0), b3, voffB); PG8_STAGE(PG8_SB(1, 1), b3 + hstep, voffB); PG8_STAGE(PG8_SA(1, 0), a3, voffA);
            PG8_WAIT_V(8); PG8_WAIT_L(0); PG8_BAR; PG8_MMA(1, 0, At, B0); PG8_MMA(1, 1, At, B1); PG8_BAR; PG8_SCHED;
            } else {
            PG8_LDB(B0, 0, 0); PG8_SCHED; PG8_LDA(At, 0, 0); PG8_STAGE(PG8_SA(1, 1), a1 + hstep, voffA);
            PG8_WAIT_L(8); PG8_BAR; PG8_WAIT_L(0); PG8_MMA(0, 0, At, B0); PG8_BAR; PG8_SCHED;
            PG8_LDB(B1, 0, 1); PG8_STAGE(PG8_SB(0, 0), b2, voffB);
            PG8_BAR; PG8_WAIT_L(0); PG8_MMA(0, 1, At, B1); PG8_BAR;
            PG8_LDA(At, 0, 1); PG8_STAGE(PG8_SA(0, 0), a2, voffA);
            PG8_BAR; PG8_WAIT_L(0); PG8_MMA(1, 0, At, B0); PG8_BAR; PG8_SCHED;
            PG8_STAGE(PG8_SB(0, 1), b2 + hstep, voffB);
            PG8_WAIT_V(6); PG8_BAR; PG8_MMA(1, 1, At, B1); PG8_BAR;
            PG8_LDB(B0, 1, 0); PG8_SCHED; PG8_LDA(At, 1, 0); PG8_STAGE(PG8_SA(0, 1), a2 + hstep, voffA);
            PG8_WAIT_L(8); PG8_BAR; PG8_WAIT_L(0); PG8_MMA(0, 0, At, B0); PG8_BAR; PG8_SCHED;
            PG8_LDB(B1, 1, 1); PG8_STAGE(PG8_SB(1, 0), b3, voffB);
            PG8_BAR; PG8_WAIT_L(0); PG8_MMA(0, 1, At, B1); PG8_BAR;
            PG8_LDA(At, 1, 1); PG8_STAGE(PG8_SA(1, 0), a3, voffA);
            PG8_BAR; PG8_WAIT_L(0); PG8_MMA(1, 0, At, B0); PG8_BAR; PG8_SCHED;
            PG8_STAGE(PG8_SB(1, 1), b3 + hstep, voffB);
            PG8_WAIT_V(6); PG8_BAR; PG8_MMA(1, 1, At, B1); PG8_BAR;
            }
        }
        if constexpr (ALIGN_EPI) { if (wr == 0) PG8_BAR; }
        if constexpr (!Epi::AFTER_DRAIN) { E(acc, cur, wr, wc, fr, fq); S.done(cur); }
        if (!has_next) break;
#pragma unroll
        for (int a = 0; a < 2; ++a)
#pragma unroll
            for (int b = 0; b < 2; ++b)
#pragma unroll
                for (int m = 0; m < 4; ++m)
#pragma unroll
                    for (int n = 0; n < 2; ++n) acc[a][b][m][n] = (f32x4){0.f, 0.f, 0.f, 0.f};
        cur = nxt; cA = nA; cB = nB; ++ui;
        if constexpr (ALIGN_EPI) { if (wr == 1) PG8_BAR; }
    }
    PG8_WAIT_V(0);
    if constexpr (!ALIGN_EPI) { if (wr == 0) PG8_BAR; }
    PG8_BAR;
    if constexpr (Epi::AFTER_DRAIN) { E.fused(acc, cur, wr, wc, fr, fq, lds, wid, lane); S.done(cur); }
#undef PG8_SA
#undef PG8_SB
#undef PG8_STAGE
#undef PG8_LDA
#undef PG8_LDB
#undef PG8_MMA
#undef PG8_WAIT_V
#undef PG8_WAIT_L
#undef PG8_BAR
#undef PG8_SCHED
}
}
namespace attn_body {
using bf16=__hip_bfloat16;
using bf16x8=__attribute__((ext_vector_type(8)))short;
using s16x4=__attribute__((ext_vector_type(4)))short;
using f32x16=__attribute__((ext_vector_type(16)))float;
using u32x4=__attribute__((ext_vector_type(4)))unsigned;
constexpr int BATCH=2,NHEAD=8,SEQ=8192,D=64,DM=NHEAD*D;
constexpr int NW=8,QBLK=32,QB=QBLK*NW,KVBLK=64,NQB=SEQ/QB;
constexpr int ATTN_PITCH=DM, ATTN_UNIT_ROWS=QB;
__device__ __forceinline__ int crow(int r,int hi){return (r&3)+8*(r>>2)+4*hi;}
#define SBAR() __builtin_amdgcn_sched_barrier(0)
__device__ __forceinline__ void cmask(f32x16&p0,f32x16&p1,int jb,int qrel,int hi){
  const float NEG=-INFINITY; int kb=64*jb+4*hi;
  #pragma unroll
  for(int r=0;r<16;++r){int kv=kb+(r&3)+8*(r>>2); if(kv>qrel)p0[r]=NEG; if(kv+32>qrel)p1[r]=NEG;}
}

constexpr int NSLOT=3, SLOTB=8192;
constexpr int LDS_K=0, LDS_V=NSLOT*SLOTB, LDS_WS=2*NSLOT*SLOTB, LDS_OST=LDS_WS+NW*64*4, LDS_KM=LDS_OST+NW*4096, LDS_BYTES=LDS_KM+32*64*4;
constexpr float C2=0.125f*1.4426950408889634f;
__device__ __forceinline__ void glds16(const void*gsrc,unsigned lds_dst){unsigned keep;
  asm volatile("s_mov_b32 %0, m0\n\ts_mov_b32 m0, %2\n\ts_nop 0\n\tglobal_load_lds_dwordx4 %1, off\n\ts_mov_b32 m0, %0":"=&s"(keep):"v"(gsrc),"s"(lds_dst):"memory");}
__device__ __forceinline__ float max3f(float a,float b,float c){float r;asm("v_max3_f32 %0, %1, %2, %3":"=v"(r):"v"(a),"v"(b),"v"(c));return r;}
__device__ __forceinline__ float max2f(float a,float b){float r;asm("v_max_f32_e32 %0, %1, %2":"=v"(r):"v"(a),"v"(b));return r;}
__device__ __forceinline__ float fadd_s(float a,float b){float r;asm("v_add_f32_e32 %0, %1, %2":"=v"(r):"v"(a),"v"(b));return r;}
__device__ __forceinline__ float fsub_s(float a,float b){float r;asm("v_sub_f32_e32 %0, %1, %2":"=v"(r):"v"(a),"v"(b));return r;}
typedef float f32x2_t __attribute__((ext_vector_type(2))); typedef __bf16 bf16x2_t __attribute__((ext_vector_type(2)));
__device__ __forceinline__ unsigned cvtpk_s(float lo,float hi){f32x2_t v={lo,hi};bf16x2_t b=__builtin_convertvector(v,bf16x2_t);return __builtin_bit_cast(unsigned,b);}
#define WAIT_BAR(N) asm volatile("s_waitcnt vmcnt(" #N ") lgkmcnt(0)\n\ts_barrier":::"memory")

__device__ __forceinline__ void qkt(f32x16&p0,f32x16&p1,const char*Kslot,const bf16x8*qr,const f32x16&negm,int r32,int hi){
  const char*kb=Kslot+hi*1024+r32*16;
  #pragma unroll
  for(int d0=0;d0<4;++d0){
    const bf16x8 b0=*reinterpret_cast<const bf16x8*>(kb+d0*2048);
    const bf16x8 b1=*reinterpret_cast<const bf16x8*>(kb+d0*2048+512);
    if(d0==0){p0=__builtin_amdgcn_mfma_f32_32x32x16_bf16(b0,qr[0],negm,0,0,0);p1=__builtin_amdgcn_mfma_f32_32x32x16_bf16(b1,qr[0],negm,0,0,0);}
    else{p0=__builtin_amdgcn_mfma_f32_32x32x16_bf16(b0,qr[d0],p0,0,0,0);p1=__builtin_amdgcn_mfma_f32_32x32x16_bf16(b1,qr[d0],p1,0,0,0);}}
}
typedef __attribute__((address_space(3))) const char* lds_cptr;
typedef short v4i16_t __attribute__((ext_vector_type(4)));
__device__ __forceinline__ void kload8(bf16x8*kf,lds_cptr kp){
  kf[0]=*(const __attribute__((address_space(3))) bf16x8*)(kp);      kf[1]=*(const __attribute__((address_space(3))) bf16x8*)(kp+512);
  kf[2]=*(const __attribute__((address_space(3))) bf16x8*)(kp+2048); kf[3]=*(const __attribute__((address_space(3))) bf16x8*)(kp+2560);
  kf[4]=*(const __attribute__((address_space(3))) bf16x8*)(kp+4096); kf[5]=*(const __attribute__((address_space(3))) bf16x8*)(kp+4608);
  kf[6]=*(const __attribute__((address_space(3))) bf16x8*)(kp+6144); kf[7]=*(const __attribute__((address_space(3))) bf16x8*)(kp+6656);
}
__device__ __forceinline__ void kload2(bf16x8*kf,lds_cptr kp,int j){ kf[2*j]=*(const __attribute__((address_space(3))) bf16x8*)(kp+j*2048); kf[2*j+1]=*(const __attribute__((address_space(3))) bf16x8*)(kp+j*2048+512); }
__device__ __forceinline__ s16x4 vtr(lds_cptr p){ return __builtin_bit_cast(s16x4,__builtin_amdgcn_ds_read_tr16_b64_v4i16((__attribute__((address_space(3))) v4i16_t*)p)); }
__device__ __forceinline__ float rowmax(const f32x16&p0,const f32x16&p1){
  float a=max3f(p0[0],p0[1],p1[0]),b=max3f(p0[2],p0[3],p1[1]);a=max3f(a,p1[2],p1[3]);
  #pragma unroll
  for(int r=4;r<16;r+=4){a=max3f(a,p0[r],p0[r+1]);b=max3f(b,p0[r+2],p0[r+3]);a=max3f(a,p1[r],p1[r+1]);b=max3f(b,p1[r+2],p1[r+3]);}
  const float m=max2f(a,b);
  auto rr=__builtin_amdgcn_permlane32_swap(__float_as_uint(m),__float_as_uint(m),false,false);
  return max2f(__uint_as_float(rr[0]),__uint_as_float(rr[1]));
}
__device__ __forceinline__ void pv(f32x16*o,int vb,bf16x8 pa0,bf16x8 pa1,bf16x8 pa2,bf16x8 pa3){
  #pragma unroll
  for(int d0=0;d0<2;++d0){s16x4 lo[4],hi[4];
    #pragma unroll
    for(int ks=0;ks<4;++ks){
      asm volatile("ds_read_b64_tr_b16 %0,%1 offset:%c2":"=&v"(lo[ks]):"v"(vb),"i"(d0*4096+ks*1024):"memory");
      asm volatile("ds_read_b64_tr_b16 %0,%1 offset:%c2":"=&v"(hi[ks]):"v"(vb),"i"(d0*4096+ks*1024+512):"memory");}
    asm volatile("s_waitcnt lgkmcnt(0)":::"memory");SBAR();
    #define PK(k) (bf16x8){lo[k][0],lo[k][1],lo[k][2],lo[k][3],hi[k][0],hi[k][1],hi[k][2],hi[k][3]}
    o[d0]=__builtin_amdgcn_mfma_f32_32x32x16_bf16(pa0,PK(0),o[d0],0,0,0);
    o[d0]=__builtin_amdgcn_mfma_f32_32x32x16_bf16(pa1,PK(1),o[d0],0,0,0);
    o[d0]=__builtin_amdgcn_mfma_f32_32x32x16_bf16(pa2,PK(2),o[d0],0,0,0);
    o[d0]=__builtin_amdgcn_mfma_f32_32x32x16_bf16(pa3,PK(3),o[d0],0,0,0);
    #undef PK
  }
}

#ifndef ATTN_STORE16
#define ATTN_STORE16(p,v) (*(u32x4*)(p)=(v))
#endif
template<int THRL> __device__ __forceinline__ void attn_unit(int b,int h,int qb,const bf16*Q,const bf16*__restrict__ K,const bf16*__restrict__ V,bf16*O,const float*__restrict__ KMG,char*shm){
  int tid_=threadIdx.x; asm volatile("":"+v"(tid_)); const int tid=tid_,lane=tid&63,r32=lane&31,hi=lane>>5; const int wid=__builtin_amdgcn_readfirstlane(tid>>6);
  const long rowbase=(long)b*SEQ; const int q0=qb*QB;
  const bf16*Qw=Q+(rowbase+q0+wid*QBLK)*DM+h*D;
  const bf16*Kh=K+rowbase*DM+h*D,*Vh=V+rowbase*DM+h*D;
  const unsigned lds0=(unsigned)(uintptr_t)shm;
  float*wsf=(float*)(shm+LDS_WS)+wid*64;
  const bf16*ksrc=Kh+(long)lane*DM+wid*8;
  const bf16*vsrc=Vh+(long)(16*(wid&3)+(lane>>2))*DM+(wid>>2)*32+(lane&3)*8;
  const unsigned kdst=lds0+LDS_K+wid*1024, vdst=lds0+LDS_V+wid*1024;
  #define TILE(p) (((p)<4)?(NT-4+(p)):((p)-4))
  #define DMA_K(t,slot) glds16(ksrc+(long)TILE(t)*KVBLK*DM,(unsigned)__builtin_amdgcn_readfirstlane(kdst+(slot)))
  #define DMA_V(t,slot) glds16(vsrc+(long)TILE(t)*KVBLK*DM,(unsigned)__builtin_amdgcn_readfirstlane(vdst+(slot)))
  const int vb0=(int)(lds0+LDS_V)+((lane>>4)&1)*32+(lane&3)*8+(4*hi+((lane&15)>>2))*64;
  const char*Kbase=shm+LDS_K; bf16x8 kf[8];
  const lds_cptr shm3=(lds_cptr)shm; const lds_cptr kp0=shm3+LDS_K+hi*1024+r32*16; const lds_cptr vp0=shm3+LDS_V+((lane>>4)&1)*32+(lane&3)*8+(4*hi+((lane&15)>>2))*64;
  const int NT=(q0+QB)/KVBLK;
  { float*kml=(float*)(shm+LDS_KM); const int idx=tid*4; const int blk=idx>>6,dd=idx&63;
    *(float4*)(kml+idx)=*(const float4*)(KMG+((long)(b*32+blk)*DM+h*D+dd)); }
  DMA_K(0,0);DMA_V(0,0);DMA_K(1,SLOTB);
  bf16x8 qr[4];
  #pragma unroll
  for(int d0=0;d0<4;++d0)qr[d0]=*reinterpret_cast<const bf16x8*>(&Qw[(long)r32*DM+d0*16+hi*8]);
  __syncthreads();
  unsigned selm=0u;
  if(qb>0){
    float qf[32];
    #pragma unroll
    for(int d0=0;d0<4;++d0){
      #pragma unroll
      for(int e=0;e<8;++e)qf[d0*8+e]=__uint_as_float(((unsigned)(unsigned short)qr[d0][e])<<16);}
    float b0=-INFINITY,b1=-INFINITY,b2=-INFINITY; int i0=-1,i1=-1,i2=-1;
    const float*kml=(const float*)(shm+LDS_KM)+hi*8;
    for(int j=0;j<qb;++j){
      float g=0.f;
      #pragma unroll
      for(int d0=0;d0<4;++d0){
        const float4 ka=*(const float4*)(kml+j*64+d0*16),kb4=*(const float4*)(kml+j*64+d0*16+4);
        g+=qf[d0*8+0]*ka.x+qf[d0*8+1]*ka.y+qf[d0*8+2]*ka.z+qf[d0*8+3]*ka.w+qf[d0*8+4]*kb4.x+qf[d0*8+5]*kb4.y+qf[d0*8+6]*kb4.z+qf[d0*8+7]*kb4.w;}
      g+=__shfl_xor(g,32);
      if(g>b0){b2=b1;i2=i1;b1=b0;i1=i0;b0=g;i0=j;}
      else if(g>b1){b2=b1;i2=i1;b1=g;i1=j;}
      else if(g>b2){b2=g;i2=j;}
    }
    if(i0>=0)selm|=1u<<i0; if(i1>=0)selm|=1u<<i1; if(i2>=0)selm|=1u<<i2;
  }
  float mhat=0.f,l_reg=0.f;f32x16 o[2];o[0]=f32x16{};o[1]=f32x16{};const f32x16 zero16=f32x16{};
  const int qrel=wid*QBLK+r32;
  #define CMASK_ROW(P0,P1,t) do{ const float pen_=((selm>>((((t)-4)>>2)&31))&1u)?-mhat:-INFINITY; _Pragma("unroll") for(int r_=0;r_<16;++r_){P0[r_]+=pen_;P1[r_]+=pen_;} }while(0)
  #define CMASK_FULL(P0,P1,t) do{ if((t)<4){ const float nm_=-mhat; _Pragma("unroll") for(int r_=0;r_<16;++r_){P0[r_]+=nm_;P1[r_]+=nm_;} cmask(P0,P1,(t),qrel,hi);} else CMASK_ROW(P0,P1,t); }while(0)
  #define CMASK(P0,P1,t) CMASK_FULL(P0,P1,t)
  bool resc=false;
  #define START(P0,P1) do{ const float rm=rowmax(P0,P1); resc=false; \
    { const float dl=rm; mhat=fadd_s(mhat,dl); \
      _Pragma("unroll") for(int r=0;r<16;++r){P0[r]=fsub_s(P0[r],dl);P1[r]=fsub_s(P1[r],dl);} \
      } \
    _Pragma("unroll") for(int r=0;r<16;++r)P0[r]=__builtin_amdgcn_exp2f(P0[r]); }while(0)
  #define RESC() do{ if(resc){ asm volatile("s_waitcnt lgkmcnt(0)":::"memory"); \
      _Pragma("unroll") for(int d_=0;d_<2;++d_) _Pragma("unroll") for(int r=0;r<16;++r)o[d_][r]*=wsf[crow(r,hi)]; } }while(0)
  f32x16 pA0,pA1,pB0,pB1;
  int sl_prev=0,sl_cur=0,sl_next=SLOTB;
  #define ROT() do{sl_prev=sl_cur;sl_cur=sl_next;sl_next=(sl_next==(NSLOT-1)*SLOTB)?0:sl_next+SLOTB;}while(0)
  DMA_K(2,2*SLOTB);
  WAIT_BAR(3);
  qkt(pA0,pA1,Kbase,qr,zero16,r32,hi);asm volatile("s_nop 15\n\ts_nop 7":"+v"(pA0),"+v"(pA1));cmask(pA0,pA1,0,qrel,hi);
  START(pA0,pA1);
  _Pragma("unroll") for(int r=0;r<16;++r)pA1[r]=__builtin_amdgcn_exp2f(pA1[r]);
  WAIT_BAR(0);
  DMA_K(3,0);DMA_V(1,SLOTB);
  ROT();
  kload8(kf,kp0+sl_cur);
  WAIT_BAR(2);
  s16x4 vlo[8],vhi[8]; u32x4 pw0,pw1,pw2,pw3;
  #define PKW(P,B) cvtpk_s(P[B],P[B+1])
  #define PAF(k) __builtin_bit_cast(bf16x8,pw##k)
  #define VFR(i) (bf16x8){vlo[i][0],vlo[i][1],vlo[i][2],vlo[i][3],vhi[i][0],vhi[i][1],vhi[i][2],vhi[i][3]}
  #define PIN(x) asm volatile("":"+v"(x))
  #define MX3(a,b,c) __builtin_fmaxf(__builtin_fmaxf((a),(b)),(c))
  #define GAPA(MF,A0,A1,A2,A3,W0,W1,PW) do{ MF; sacc+=A0; sacc+=A1; sacc+=A2; sacc+=A3; PIN(sacc); W0; W1; PIN(PW); SBAR(); }while(0)
  #define EX(v) __builtin_amdgcn_exp2f(v)
  #define GAPB(MF,X,B) do{ MF; X[B]=EX(X[B]); X[B+1]=EX(X[B+1]); X[B+2]=EX(X[B+2]); X[B+3]=EX(X[B+3]); PIN(X); SBAR(); }while(0)
  #define VRD(i) do{ vlo[i]=vtr(vp_+(((i)>>2)*4096+((i)&3)*1024)); vhi[i]=vtr(vp_+(((i)>>2)*4096+((i)&3)*1024+512)); }while(0)
  #define KRD(G,j) do{ if(G){ kload2(kf,kp0+sl_next,j); SBAR(); } }while(0)
  #define STEP(C0,C1,P0,P1,t,GK,GV,GL) do{ SBAR(); \
    const lds_cptr vp_=vp0+sl_prev; \
    VRD(0); SBAR(); float sacc=(P0[0]+P0[1]); \
    GAPA(C0=__builtin_amdgcn_mfma_f32_32x32x16_bf16(kf[0],qr[0],zero16,0,0,0), P0[2],P0[3],P0[4],P0[5],     pw0[0]=PKW(P0,0), pw0[1]=PKW(P0,2), pw0); \
    VRD(4); SBAR(); GAPA(C1=__builtin_amdgcn_mfma_f32_32x32x16_bf16(kf[1],qr[0],zero16,0,0,0), P0[6],P0[7],P0[8],P0[9],     pw0[2]=PKW(P0,4), pw0[3]=PKW(P0,6), pw0); \
    VRD(1); SBAR(); GAPA(C0=__builtin_amdgcn_mfma_f32_32x32x16_bf16(kf[2],qr[1],C0,0,0,0),   P0[10],P0[11],P0[12],P0[13], pw1[0]=PKW(P0,8), pw1[1]=PKW(P0,10), pw1); \
    VRD(5); SBAR(); GAPA(C1=__builtin_amdgcn_mfma_f32_32x32x16_bf16(kf[3],qr[1],C1,0,0,0),   P0[14],P0[15],P1[0],P1[1],   pw1[2]=PKW(P0,12),pw1[3]=PKW(P0,14), pw1); \
    VRD(2); SBAR(); GAPA(C0=__builtin_amdgcn_mfma_f32_32x32x16_bf16(kf[4],qr[2],C0,0,0,0),   P1[2],P1[3],P1[4],P1[5],     pw2[0]=PKW(P1,0), pw2[1]=PKW(P1,2), pw2); \
    VRD(6); SBAR(); GAPA(C1=__builtin_amdgcn_mfma_f32_32x32x16_bf16(kf[5],qr[2],C1,0,0,0),   P1[6],P1[7],P1[8],P1[9],     pw2[2]=PKW(P1,4), pw2[3]=PKW(P1,6), pw2); \
    VRD(3); SBAR(); GAPA(C0=__builtin_amdgcn_mfma_f32_32x32x16_bf16(kf[6],qr[3],C0,0,0,0),   P1[10],P1[11],P1[12],P1[13], pw3[0]=PKW(P1,8), pw3[1]=PKW(P1,10), pw3); \
    VRD(7); SBAR(); GAPA(C1=__builtin_amdgcn_mfma_f32_32x32x16_bf16(kf[7],qr[3],C1,0,0,0),   P1[14],P1[15],0.f,0.f,       pw3[2]=PKW(P1,12),pw3[3]=PKW(P1,14), pw3); \
    l_reg+=sacc; \
    if(GK){DMA_K((t)+3,sl_cur);} if(GV){DMA_V((t)+1,sl_next);} \
    CMASK(C0,C1,t); \
    { float a=MX3(C0[0],C0[1],C1[0]),b=MX3(C0[2],C0[3],C1[1]); a=MX3(a,C1[2],C1[3]); \
      _Pragma("unroll") for(int r=4;r<16;r+=4){a=MX3(a,C0[r],C0[r+1]);b=MX3(b,C0[r+2],C0[r+3]);a=MX3(a,C1[r],C1[r+1]);b=MX3(b,C1[r+2],C1[r+3]);} \
      float rm=__builtin_fmaxf(a,b); { auto rr=__builtin_amdgcn_permlane32_swap(__float_as_uint(rm),__float_as_uint(rm),false,false); rm=__builtin_fmaxf(__uint_as_float(rr[0]),__uint_as_float(rr[1])); } \
      resc=false; \
      if(__builtin_expect(__any(rm>(float)THRL),0)){ const float dl=__builtin_fmaxf(rm,0.f); mhat+=dl; \
        _Pragma("unroll") for(int r=0;r<16;++r){C0[r]-=dl;C1[r]-=dl;} \
        const float f=__builtin_amdgcn_exp2f(-dl); l_reg*=f; if(hi==0)wsf[r32]=f; resc=true; } } \
    SBAR(); \
    GAPB(o[0]=__builtin_amdgcn_mfma_f32_32x32x16_bf16(PAF(0),VFR(0),o[0],0,0,0), C0,0); \
    GAPB(o[1]=__builtin_amdgcn_mfma_f32_32x32x16_bf16(PAF(0),VFR(4),o[1],0,0,0), C0,4); \
    KRD(GL,0); GAPB(o[0]=__builtin_amdgcn_mfma_f32_32x32x16_bf16(PAF(1),VFR(1),o[0],0,0,0), C0,8); \
    KRD(GL,1); GAPB(o[1]=__builtin_amdgcn_mfma_f32_32x32x16_bf16(PAF(1),VFR(5),o[1],0,0,0), C0,12); \
    KRD(GL,2); GAPB(o[0]=__builtin_amdgcn_mfma_f32_32x32x16_bf16(PAF(2),VFR(2),o[0],0,0,0), C1,0); \
    KRD(GL,3); GAPB(o[1]=__builtin_amdgcn_mfma_f32_32x32x16_bf16(PAF(2),VFR(6),o[1],0,0,0), C1,4); \
    GAPB(o[0]=__builtin_amdgcn_mfma_f32_32x32x16_bf16(PAF(3),VFR(3),o[0],0,0,0), C1,8); \
    GAPB(o[1]=__builtin_amdgcn_mfma_f32_32x32x16_bf16(PAF(3),VFR(7),o[1],0,0,0), C1,12); \
    }while(0)
  int t=1;
  #define ENDW(tt) do{ if((tt)+3<NT){WAIT_BAR(2);} else if((tt)+2<NT){WAIT_BAR(1);} else {WAIT_BAR(0);} }while(0)
  for(;t<5&&t+1<NT;t+=2){
    STEP(pB0,pB1,pA0,pA1,t,(t+3<NT),(t+1<NT),(t+1<NT));       ENDW(t);   RESC(); ROT();
    STEP(pA0,pA1,pB0,pB1,t+1,(t+4<NT),(t+2<NT),(t+2<NT));     ENDW(t+1); RESC(); ROT();
  }
  #undef CMASK
  #define CMASK(P0,P1,t) CMASK_ROW(P0,P1,t)
  for(;t+5<NT;t+=2){
    STEP(pB0,pB1,pA0,pA1,t,true,true,true);     WAIT_BAR(2); RESC(); ROT();
    STEP(pA0,pA1,pB0,pB1,t+1,true,true,true);   WAIT_BAR(2); RESC(); ROT();
  }
  for(;t+1<NT;t+=2){
    STEP(pB0,pB1,pA0,pA1,t,(t+3<NT),(t+1<NT),(t+1<NT));       ENDW(t);   RESC(); ROT();
    STEP(pA0,pA1,pB0,pB1,t+1,(t+4<NT),(t+2<NT),(t+2<NT));     ENDW(t+1); RESC(); ROT();
  }
  #undef CMASK
  #define CMASK(P0,P1,t) CMASK_FULL(P0,P1,t)
  STEP(pB0,pB1,pA0,pA1,NT-1,false,false,false); RESC();
  { float sacc=pB0[0]+pB0[1]; _Pragma("unroll") for(int r=2;r<16;++r)sacc+=pB0[r]; _Pragma("unroll") for(int r=0;r<16;++r)sacc+=pB1[r]; l_reg+=sacc;
    pw0=(u32x4){PKW(pB0,0),PKW(pB0,2),PKW(pB0,4),PKW(pB0,6)};pw1=(u32x4){PKW(pB0,8),PKW(pB0,10),PKW(pB0,12),PKW(pB0,14)};pw2=(u32x4){PKW(pB1,0),PKW(pB1,2),PKW(pB1,4),PKW(pB1,6)};pw3=(u32x4){PKW(pB1,8),PKW(pB1,10),PKW(pB1,12),PKW(pB1,14)};
    SBAR(); pv(o,vb0+sl_cur,PAF(0),PAF(1),PAF(2),PAF(3)); }
  #undef PKW
  #undef PAF
  #undef VFR
  #undef PIN
  #undef MX3
  #undef GAPA
  #undef GAPB
  #undef EX
  #undef VRD
  #undef KRD
  #undef STEP
  #undef ENDW
  {auto rr=__builtin_amdgcn_permlane32_swap(__float_as_uint(l_reg),__float_as_uint(l_reg),false,false);l_reg=__uint_as_float(rr[0])+__uint_as_float(rr[1]);}
  if(hi==0)wsf[32+r32]=l_reg;asm volatile("s_waitcnt lgkmcnt(0)":::"memory");
  float rli[16];
  #pragma unroll
  for(int r=0;r<16;++r)rli[r]=__builtin_amdgcn_rcpf(wsf[32+crow(r,hi)]);
  bf16*Ow=O+(rowbase+q0+wid*QBLK)*DM+h*D;
  { bf16*stg=(bf16*)(shm+LDS_OST)+wid*2048;
    #pragma unroll
    for(int r=0;r<16;++r){const int orow=crow(r,hi);
      #pragma unroll
      for(int d0=0;d0<2;++d0)stg[orow*64+d0*32+r32]=__float2bfloat16(o[d0][r]*rli[r]);}
    asm volatile("s_waitcnt lgkmcnt(0)":::"memory");
    #pragma unroll
    for(int i=0;i<4;++i){const int row=i*8+(lane>>3),ch=lane&7; const u32x4 v=*(const u32x4*)(stg+row*64+ch*8); ATTN_STORE16(Ow+(long)row*DM+ch*8,v);} }
  asm volatile("s_waitcnt lgkmcnt(0)\n\ts_barrier":::"memory");
  #undef DMA_K
  #undef TILE
  #undef DMA_V
  #undef CMASK
  #undef CMASK_ROW
  #undef CMASK_FULL
  #undef START
  #undef RESC
  #undef ROT
}
constexpr int ATTN_LDS_BYTES=LDS_BYTES;
struct AttnTensors { const bf16* Q; const bf16* K; const bf16* V; bf16* O; const float* KM; };
struct AttnUnit { int bh; int qb; };
struct StaticOrder {
  int vcu,G;
  __device__ __forceinline__ explicit StaticOrder(int grid,int block):vcu((grid%8==0)?(block%8)*(grid/8)+block/8:block),G(grid){}
  __device__ __forceinline__ bool next(int i,AttnUnit&u)const{ const int pr=(i>>1)*G+vcu; if(pr>=256)return false; const int s=pr&15; u.bh=pr>>4; u.qb=(i&1)?31-s:s; return true; }
};
template<class Sched,int THRL=8> __device__ __forceinline__ void attn_phase(char*lds,const AttnTensors&T,const Sched&S){
  AttnUnit u;
  for(int i=0;S.next(i,u);++i){ attn_unit<THRL>(u.bh/NHEAD,u.bh%NHEAD,u.qb,T.Q,T.K,T.V,T.O,T.KM,lds); }
}
#undef SBAR
#undef WAIT_BAR
}
namespace mk {
typedef unsigned short bf16;
typedef float f32x4 __attribute__((ext_vector_type(4)));
typedef float f32x2 __attribute__((ext_vector_type(2)));
typedef unsigned u32x4 __attribute__((ext_vector_type(4)));
typedef unsigned u32x2 __attribute__((ext_vector_type(2)));
typedef short bf16x8 __attribute__((ext_vector_type(8)));
typedef __bf16 bf16x2_t __attribute__((ext_vector_type(2)));

constexpr int NWV = 8, NTHR = 512;
constexpr int SEQ = 8192, TOK = 2 * SEQ, DM = 1024, FF = 2816, NIN = 6656, CW = 512, NLAYER = 2;
constexpr float EPS = 1e-6f;
constexpr float C2 = 0.125f * 1.4426950408889634f;
constexpr size_t MiB = 1u << 20;
constexpr size_t WS_ROPE = 1 * MiB, WS_KMEAN = 2 * MiB;
constexpr size_t WS_WFI = 4 * MiB, WS_WFO = 15 * MiB, WS_WIN = 21 * MiB, WS_WBR = 34 * MiB, WS_WOUT = 37 * MiB;
constexpr size_t WS_XN = 40 * MiB, WS_YA = 40 * MiB, WS_YB = 56 * MiB, WS_Q = 72 * MiB, WS_K = 88 * MiB, WS_V = 104 * MiB;
constexpr size_t WS_GLU = 120 * MiB, WS_U = 136 * MiB, WS_SV = 152 * MiB, WS_GATES = 168 * MiB, WS_END = 264 * MiB;
constexpr size_t WS_ACT = 72 * MiB, WS_MERGED = 120 * MiB;
constexpr int LDS_BYTES = 135168;

__device__ __forceinline__ float bf2f(unsigned h) { return __uint_as_float(h << 16); }
__device__ __forceinline__ float bflo(unsigned u) { return __uint_as_float(u << 16); }
__device__ __forceinline__ float bfhi(unsigned u) { return __uint_as_float(u & 0xffff0000u); }
__device__ __forceinline__ unsigned pk2(float lo, float hi) { f32x2 v = {lo, hi}; bf16x2_t b = __builtin_convertvector(v, bf16x2_t); return __builtin_bit_cast(unsigned, b); }
__device__ __forceinline__ float sigm(float a) { return __builtin_amdgcn_rcpf(1.f + __builtin_amdgcn_exp2f(-1.4426950408889634f * a)); }
__device__ __forceinline__ float gelu_tanh(float x) { return x * sigm(1.5957691216057308f * (x + 0.044715f * x * x * x)); }
__device__ __forceinline__ float wave_sum(float v) {
#pragma unroll
    for (int o = 1; o < 64; o <<= 1) v += __shfl_xor(v, o);
    return v;
}
__device__ __forceinline__ void store8(bf16* p, f32x4 a, f32x4 b) { u32x4 w; w.x = pk2(a[0], a[1]); w.y = pk2(a[2], a[3]); w.z = pk2(b[0], b[1]); w.w = pk2(b[2], b[3]); *(u32x4*)p = w; }
__device__ __forceinline__ void unpack8(u32x4 w, f32x4& a, f32x4& b) { a = (f32x4){bflo(w.x), bfhi(w.x), bflo(w.y), bfhi(w.y)}; b = (f32x4){bflo(w.z), bfhi(w.z), bflo(w.w), bfhi(w.w)}; }

struct EpiSwiGLU {
    static constexpr bool PERM = true, AFTER_DRAIN = false;
    bf16* O; int ldc;
    __device__ __forceinline__ void operator()(const f32x4 (&acc)[2][2][4][2], const pg8::Unit& u, int wr, int wc, int fr, int fq) const {
        const int row0 = u.pm * 256 + wr * 64 + fr, col = u.pn * 128 + wc * 32 + 8 * fq;
#pragma unroll
        for (int ai = 0; ai < 2; ++ai)
#pragma unroll
            for (int m = 0; m < 4; ++m) {
                f32x4 o0, o1;
#pragma unroll
                for (int e = 0; e < 4; ++e) { const float g0 = acc[ai][0][m][0][e], g1 = acc[ai][0][m][1][e]; o0[e] = g0 * sigm(g0) * acc[ai][1][m][0][e]; o1[e] = g1 * sigm(g1) * acc[ai][1][m][1][e]; }
                store8(O + (size_t)(row0 + ai * 128 + m * 16) * ldc + col, o0, o1);
            }
    }
};
struct EpiResid {
    static constexpr bool PERM = true, AFTER_DRAIN = false;
    const float* base; float* out; float scale;
    __device__ __forceinline__ void operator()(const f32x4 (&acc)[2][2][4][2], const pg8::Unit& u, int wr, int wc, int fr, int fq) const {
        const int row0 = u.pm * 256 + wr * 64 + fr, col0 = u.pn * 256 + wc * 32 + 8 * fq;
#pragma unroll
        for (int ai = 0; ai < 2; ++ai)
#pragma unroll
            for (int m = 0; m < 4; ++m)
#pragma unroll
                for (int bj = 0; bj < 2; ++bj) {
                    const size_t off = (size_t)(row0 + ai * 128 + m * 16) * DM + col0 + bj * 128;
                    const f32x4 b0 = *(const f32x4*)(base + off), b1 = *(const f32x4*)(base + off + 4);
                    *(f32x4*)(out + off) = b0 + acc[ai][bj][m][0] * scale; *(f32x4*)(out + off + 4) = b1 + acc[ai][bj][m][1] * scale;
                }
    }
};
struct EpiWin {
    static constexpr bool PERM = true, AFTER_DRAIN = false;
    bf16 *GLU, *U, *SV, *Q, *K, *V, *GATES; const float* gate_b; const float* rope;
    __device__ __forceinline__ void operator()(const f32x4 (&acc)[2][2][4][2], const pg8::Unit& u, int wr, int wc, int fr, int fq) const {
        const int pn = u.pn, row0 = u.pm * 256 + wr * 64 + fr, cw = wc * 32 + 8 * fq;
        if (pn < 4) {
#pragma unroll
            for (int ai = 0; ai < 2; ++ai)
#pragma unroll
                for (int m = 0; m < 4; ++m) {
                    f32x4 o0, o1;
#pragma unroll
                    for (int e = 0; e < 4; ++e) { o0[e] = acc[ai][0][m][0][e] * sigm(acc[ai][1][m][0][e]); o1[e] = acc[ai][0][m][1][e] * sigm(acc[ai][1][m][1][e]); }
                    store8(GLU + (size_t)(row0 + ai * 128 + m * 16) * CW + pn * 128 + cw, o0, o1);
                }
        } else if (pn < 8) {
            bf16* dst = (pn < 6) ? U : SV; const int cb = (pn & 1) * 256 + cw;
#pragma unroll
            for (int ai = 0; ai < 2; ++ai)
#pragma unroll
                for (int m = 0; m < 4; ++m)
#pragma unroll
                    for (int bj = 0; bj < 2; ++bj) {
                        f32x4 o0, o1;
#pragma unroll
                        for (int e = 0; e < 4; ++e) { o0[e] = gelu_tanh(acc[ai][bj][m][0][e]); o1[e] = gelu_tanh(acc[ai][bj][m][1][e]); }
                        store8(dst + (size_t)(row0 + ai * 128 + m * 16) * CW + cb + bj * 128, o0, o1);
                    }
        } else if (pn < 12) {
            bf16* dst = (pn < 10) ? Q : K; const float sc = (pn < 10) ? C2 : 1.f; const int cb = (pn & 1) * 256 + cw;
            const bool ropew = (wc & 1) == 0;
#pragma unroll
            for (int ai = 0; ai < 2; ++ai)
#pragma unroll
                for (int m = 0; m < 4; ++m) {
                    const int row = row0 + ai * 128 + m * 16, pos = row & (SEQ - 1);
                    f32x4 c0 = {1.f, 1.f, 1.f, 1.f}, c1 = c0, s0 = {0.f, 0.f, 0.f, 0.f}, s1 = s0;
                    if (ropew && fq < 2) { c0 = *(const f32x4*)(rope + pos * 8); c1 = *(const f32x4*)(rope + pos * 8 + 4); s0 = *(const f32x4*)(rope + SEQ * 8 + pos * 8); s1 = *(const f32x4*)(rope + SEQ * 8 + pos * 8 + 4); }
                    if (fq == 0) { s0 = -s0; s1 = -s1; }
#pragma unroll
                    for (int bj = 0; bj < 2; ++bj) {
                        f32x4 v0 = acc[ai][bj][m][0], v1 = acc[ai][bj][m][1];
                        if (ropew) {
                            f32x4 p0, p1;
#pragma unroll
                            for (int e = 0; e < 4; ++e) { p0[e] = __shfl_xor(v0[e], 16); p1[e] = __shfl_xor(v1[e], 16); }
                            v0 = v0 * c0 + p0 * s0; v1 = v1 * c1 + p1 * s1;
                        }
                        store8(dst + (size_t)row * CW + cb + bj * 128, v0 * sc, v1 * sc);
                    }
                }
        } else if (pn < 14) {
            const int cb = (pn & 1) * 256 + cw;
#pragma unroll
            for (int ai = 0; ai < 2; ++ai)
#pragma unroll
                for (int m = 0; m < 4; ++m)
#pragma unroll
                    for (int bj = 0; bj < 2; ++bj) store8(V + (size_t)(row0 + ai * 128 + m * 16) * CW + cb + bj * 128, acc[ai][bj][m][0], acc[ai][bj][m][1]);
        } else {
            const int gc = (pn - 14) * 256 + cw;
#pragma unroll
            for (int bj = 0; bj < 2; ++bj) {
                const f32x4 bb0 = *(const f32x4*)(gate_b + gc + bj * 128), bb1 = *(const f32x4*)(gate_b + gc + bj * 128 + 4);
#pragma unroll
                for (int ai = 0; ai < 2; ++ai)
#pragma unroll
                    for (int m = 0; m < 4; ++m) {
                        f32x4 o0, o1;
#pragma unroll
                        for (int e = 0; e < 4; ++e) { o0[e] = sigm(acc[ai][bj][m][0][e] + bb0[e]); o1[e] = sigm(acc[ai][bj][m][1][e] + bb1[e]); }
                        store8(GATES + (size_t)(row0 + ai * 128 + m * 16) * 3072 + gc + bj * 128, o0, o1);
                    }
            }
        }
    }
};
struct EpiBranch {
    static constexpr bool PERM = true, AFTER_DRAIN = false;
    const bf16* GATES; bf16* MERGED;
    __device__ __forceinline__ void operator()(const f32x4 (&acc)[2][2][4][2], const pg8::Unit& u, int wr, int wc, int fr, int fq) const {
        const int br = u.pm >> 6, row0 = (u.pm & 63) * 256 + wr * 64 + fr, col0 = (u.pn & 3) * 256 + wc * 32 + 8 * fq;
#pragma unroll
        for (int ai = 0; ai < 2; ++ai)
#pragma unroll
            for (int m = 0; m < 4; ++m)
#pragma unroll
                for (int bj = 0; bj < 2; ++bj) {
                    const int row = row0 + ai * 128 + m * 16, col = col0 + bj * 128;
                    f32x4 g0, g1; unpack8(*(const u32x4*)(GATES + (size_t)row * 3072 + br * 1024 + col), g0, g1);
                    f32x4 o0 = g0 * acc[ai][bj][m][0], o1 = g1 * acc[ai][bj][m][1];
                    bf16* mp = MERGED + (size_t)row * DM + col;
                    if (br > 0) { f32x4 p0, p1; unpack8(*(const u32x4*)mp, p0, p1); o0 += p0; o1 += p1; }
                    store8(mp, o0, o1);
                }
    }
};
struct BranchOrder {
    pg8::StaticOrder base;
    __device__ __forceinline__ bool next(int r, pg8::Unit& u) const { pg8::Unit t; if (!base.next(r / 3, t)) return false; const int i = r % 3; u.pm = i * 64 + t.pm; u.pn = i * 4 + t.pn; return true; }
    __device__ __forceinline__ void a_ready(const pg8::Unit&) const {}
    __device__ __forceinline__ void done(const pg8::Unit&) const {}
};

struct Frame { unsigned char* lds; int tid, lane, wave, G, gw, ngw; };
__device__ __forceinline__ void frame_refresh(Frame& F) { int t = threadIdx.x; asm volatile("" : "+v"(t)); F.tid = t; F.lane = t & 63; F.wave = __builtin_amdgcn_readfirstlane(t >> 6); F.gw = blockIdx.x * NWV + F.wave; }

__device__ __forceinline__ int map_row(int mode, int n) {
    if (mode == 1) { const int up = n >= FF, j = up ? n - FF : n; return 256 * (j >> 7) + (up ? 128 : 0) + (j & 127); }
    if (mode == 2) { if (n >= 1024) return n; const int j = n & 511; return 256 * (j >> 7) + ((n >> 9) ? 128 : 0) + (j & 127); }
    return n;
}
__device__ __forceinline__ void cvt_weight(const Frame& F, const float* __restrict__ W, int K, int N, bf16* WT, int mode) {
    float* scr = (float*)(F.lds + F.wave * 16384);
    const int nblk = N / 32, nitems = (K / 64) * nblk, lane = F.lane;
    for (int item = F.gw; item < nitems; item += F.ngw) {
        const int kb = item / nblk, nb = item % nblk, k0 = 64 * kb, n0 = 32 * nb;
#pragma unroll 8
        for (int i = 0; i < 32; ++i) { const int kk = 2 * i + (lane >> 5); scr[kk * 33 + (lane & 31)] = W[(size_t)(k0 + kk) * N + n0 + (lane & 31)]; }
        asm volatile("s_waitcnt lgkmcnt(0)" ::: "memory");
        const int c = lane & 7, r0 = map_row(mode, n0);
#pragma unroll
        for (int j = 0; j < 4; ++j) { const int n = (lane >> 3) + 8 * j; const float* s = scr + (8 * c) * 33 + n;
            u32x4 o; o.x = pk2(s[0 * 33], s[1 * 33]); o.y = pk2(s[2 * 33], s[3 * 33]); o.z = pk2(s[4 * 33], s[5 * 33]); o.w = pk2(s[6 * 33], s[7 * 33]);
            *(u32x4*)(WT + (size_t)(r0 + n) * K + k0 + 8 * c) = o; }
        asm volatile("s_waitcnt lgkmcnt(0)" ::: "memory");
    }
}
__device__ __forceinline__ void norm_rows(const Frame& F, const float* x, const float* __restrict__ g, bf16* xn) {
    f32x4 gv[4];
#pragma unroll
    for (int j = 0; j < 4; ++j) gv[j] = ((const f32x4*)g)[F.lane + 64 * j];
    for (int m = F.gw; m < TOK; m += F.ngw) {
        const f32x4* xr = (const f32x4*)(x + (size_t)m * DM) + F.lane; f32x4 v[4]; float s = 0.f;
#pragma unroll
        for (int j = 0; j < 4; ++j) { v[j] = xr[64 * j]; s += (v[j].x * v[j].x + v[j].y * v[j].y) + (v[j].z * v[j].z + v[j].w * v[j].w); }
        const float rs = 1.0f / sqrtf(wave_sum(s) * (1.f / DM) + EPS);
        u32x2* o = (u32x2*)(xn + (size_t)m * DM) + F.lane;
#pragma unroll
        for (int j = 0; j < 4; ++j) { const f32x4 y = v[j] * rs * gv[j]; u32x2 w; w.x = pk2(y.x, y.y); w.y = pk2(y.z, y.w); o[64 * j] = w; }
    }
}
__device__ __forceinline__ void final_norm_rows(const Frame& F, float* x, const float* __restrict__ g) {
    f32x4 gv[4];
#pragma unroll
    for (int j = 0; j < 4; ++j) gv[j] = ((const f32x4*)g)[F.lane + 64 * j];
    for (int m = F.gw; m < TOK; m += F.ngw) {
        f32x4* xr = (f32x4*)(x + (size_t)m * DM) + F.lane; f32x4 v[4]; float s = 0.f;
#pragma unroll
        for (int j = 0; j < 4; ++j) { v[j] = xr[64 * j]; s += (v[j].x * v[j].x + v[j].y * v[j].y) + (v[j].z * v[j].z + v[j].w * v[j].w); }
        const float rs = 1.0f / sqrtf(wave_sum(s) * (1.f / DM) + EPS);
#pragma unroll
        for (int j = 0; j < 4; ++j) xr[64 * j] = v[j] * rs * gv[j];
    }
}
__device__ __forceinline__ void rope_tables(const Frame& F, float* rope) {
    const float invf[8] = {1.0f, 0.1939227432012558f, 0.03760603070259094f, 0.007292664609849453f, 0.0014142135623842478f, 0.00027424818836152554f, 5.318296098266728e-05f, 1.0313386155758053e-05f};
    for (int idx = blockIdx.x * NTHR + F.tid; idx < SEQ * 8; idx += F.G * NTHR) {
        const int pos = idx >> 3, i = idx & 7;
        float fi = invf[0];
#pragma unroll
        for (int k = 1; k < 8; ++k) fi = (i == k) ? invf[k] : fi;
        const float ang = (float)pos * fi;
        const double rev = (double)ang * 0.15915494309189535; const float fr = (float)(rev - __builtin_rint(rev));
        rope[idx] = __builtin_amdgcn_cosf(fr); rope[SEQ * 8 + idx] = __builtin_amdgcn_sinf(fr);
    }
}

struct MixP { const bf16 *GLU, *U, *SV, *K; bf16 *YA, *YB; float* KMEAN;
              const float *conv_w, *conv_b, *cln_g, *cln_b, *sln_g, *sln_b, *sgu_w, *sgu_b; };

__device__ __forceinline__ void kmean_item(const Frame& F, const MixP& P, int ki) {
    const size_t base = (size_t)ki * 256; float a[8];
#pragma unroll
    for (int e = 0; e < 8; ++e) a[e] = 0.f;
#pragma unroll 8
    for (int i = 0; i < 32; ++i) { f32x4 x0, x1; unpack8(*(const u32x4*)(P.K + (base + F.wave * 32 + i) * CW + F.lane * 8), x0, x1);
#pragma unroll
        for (int e = 0; e < 4; ++e) { a[e] += x0[e]; a[4 + e] += x1[e]; } }
    float* part = (float*)F.lds;
#pragma unroll
    for (int e = 0; e < 8; ++e) part[F.wave * 512 + F.lane * 8 + e] = a[e];
    __syncthreads();
    float s = 0.f;
#pragma unroll
    for (int w = 0; w < 8; ++w) s += part[w * 512 + F.tid];
    P.KMEAN[(size_t)ki * CW + F.tid] = s * (1.f / 256.f);
    __syncthreads();
}
__device__ __forceinline__ void conv_item(const Frame& F, const MixP& P, int ci) {
    bf16* in_t = (bf16*)F.lds;
    float* out_t = (float*)(F.lds + 63488);
    const int t0 = ci * 32, tin = t0 & (SEQ - 1), tid = F.tid;
    for (int idx = tid; idx < 62 * 64; idx += NTHR) { const int r = idx >> 6, ch = idx & 63; u32x4 v = {0u, 0u, 0u, 0u};
        if (tin - 30 + r >= 0) v = *(const u32x4*)(P.GLU + (size_t)(t0 - 30 + r) * CW + ch * 8);
        *(u32x4*)(in_t + r * CW + ch * 8) = v; }
    __syncthreads();
    {
        const int cp = tid & 255, th = tid >> 8;
        float w0[31], w1[31];
#pragma unroll
        for (int k = 0; k < 31; ++k) { const f32x2 w = *(const f32x2*)(P.conv_w + k * CW + 2 * cp); w0[k] = w.x; w1[k] = w.y; }
        const f32x2 bb = *(const f32x2*)(P.conv_b + 2 * cp);
#pragma unroll 1
        for (int tt = 0; tt < 16; ++tt) { const int t = th * 16 + tt; float a0 = bb.x, a1 = bb.y;
#pragma unroll
            for (int k = 0; k < 31; ++k) { const unsigned uv = *(const unsigned*)(in_t + (t + k) * CW + 2 * cp); a0 += w0[k] * bflo(uv); a1 += w1[k] * bfhi(uv); }
            *(f32x2*)(out_t + t * CW + 2 * cp) = (f32x2){a0, a1}; }
    }
    __syncthreads();
    {
        const int lane = F.lane; f32x4 g0 = *(const f32x4*)(P.cln_g + lane * 8), g1 = *(const f32x4*)(P.cln_g + lane * 8 + 4), b0 = *(const f32x4*)(P.cln_b + lane * 8), b1 = *(const f32x4*)(P.cln_b + lane * 8 + 4);
#pragma unroll
        for (int i = 0; i < 4; ++i) { const int t = F.wave * 4 + i;
            f32x4 v0 = *(const f32x4*)(out_t + t * CW + lane * 8), v1 = *(const f32x4*)(out_t + t * CW + lane * 8 + 4);
            const float mean = wave_sum((v0.x + v0.y) + (v0.z + v0.w) + (v1.x + v1.y) + (v1.z + v1.w)) * (1.f / CW);
            v0 = v0 - mean; v1 = v1 - mean;
            const float var = wave_sum((v0.x * v0.x + v0.y * v0.y) + (v0.z * v0.z + v0.w * v0.w) + (v1.x * v1.x + v1.y * v1.y) + (v1.z * v1.z + v1.w * v1.w)) * (1.f / CW);
            const float rstd = 1.0f / sqrtf(var + EPS);
            f32x4 y0 = v0 * rstd * g0 + b0, y1 = v1 * rstd * g1 + b1;
#pragma unroll
            for (int e = 0; e < 4; ++e) { y0[e] = y0[e] * sigm(y0[e]); y1[e] = y1[e] * sigm(y1[e]); }
            store8(P.YA + (size_t)(t0 + t) * CW + lane * 8, y0, y1); }
    }
    __syncthreads();
}
__device__ __forceinline__ void sgu_item(const Frame& F, const MixP& P, int si) {
    const int chunk = si >> 2, g = si & 3, tb = chunk * 128, lane = F.lane, wave = F.wave;
    bf16* vT = (bf16*)F.lds;
    {
        const f32x4 g0 = *(const f32x4*)(P.sln_g + lane * 8), g1 = *(const f32x4*)(P.sln_g + lane * 8 + 4), b0 = *(const f32x4*)(P.sln_b + lane * 8), b1 = *(const f32x4*)(P.sln_b + lane * 8 + 4);
#pragma unroll 4
        for (int i = 0; i < 16; ++i) { const int s = wave * 16 + i; f32x4 v0, v1; unpack8(*(const u32x4*)(P.SV + (size_t)(tb + s) * CW + lane * 8), v0, v1);
            const float mean = wave_sum((v0.x + v0.y) + (v0.z + v0.w) + (v1.x + v1.y) + (v1.z + v1.w)) * (1.f / CW);
            v0 = v0 - mean; v1 = v1 - mean;
            const float var = wave_sum((v0.x * v0.x + v0.y * v0.y) + (v0.z * v0.z + v0.w * v0.w) + (v1.x * v1.x + v1.y * v1.y) + (v1.z * v1.z + v1.w * v1.w)) * (1.f / CW);
            const float rstd = 1.0f / sqrtf(var + EPS);
            const f32x4 y0 = v0 * rstd * g0 + b0, y1 = v1 * rstd * g1 + b1;
            if ((lane >> 4) == g) { bf16* d = vT + ((lane & 15) * 8) * 136 + s;
#pragma unroll
                for (int e = 0; e < 4; ++e) { d[e * 136] = (bf16)(pk2(y0[e], 0.f) & 0xffffu); d[(4 + e) * 136] = (bf16)(pk2(y1[e], 0.f) & 0xffffu); } } }
    }
    __syncthreads();
    {
        const int t0 = wave * 16, fr = lane & 15, fq = lane >> 4, t = t0 + fr;
        f32x4 acc[8];
#pragma unroll
        for (int cb = 0; cb < 8; ++cb) acc[cb] = (f32x4){0.f, 0.f, 0.f, 0.f};
        const float* Wrow = P.sgu_w + ((size_t)g * 128 + t) * 128;
        for (int s0 = 0; s0 < t0 + 16; s0 += 32) { const int sb = s0 + 8 * fq;
            const f32x4 wa = *(const f32x4*)(Wrow + sb), wb = *(const f32x4*)(Wrow + sb + 4);
            float wv[8] = {wa.x, wa.y, wa.z, wa.w, wb.x, wb.y, wb.z, wb.w};
#pragma unroll
            for (int e = 0; e < 8; ++e) wv[e] = (sb + e <= t) ? wv[e] : 0.f;
            u32x4 wp; wp.x = pk2(wv[0], wv[1]); wp.y = pk2(wv[2], wv[3]); wp.z = pk2(wv[4], wv[5]); wp.w = pk2(wv[6], wv[7]);
            const bf16x8 wf = __builtin_bit_cast(bf16x8, wp);
#pragma unroll
            for (int cb = 0; cb < 8; ++cb) { const bf16x8 vf = *(const bf16x8*)(vT + (16 * cb + fr) * 136 + sb); acc[cb] = __builtin_amdgcn_mfma_f32_16x16x32_bf16(vf, wf, acc[cb], 0, 0, 0); } }
        const float bs = P.sgu_b[g * 128 + t];
#pragma unroll
        for (int cb = 0; cb < 8; ++cb) { const size_t off = (size_t)(tb + t) * CW + g * 128 + 16 * cb + 4 * fq; const u32x2 ur = *(const u32x2*)(P.U + off);
            u32x2 o; o.x = pk2(bflo(ur.x) * (acc[cb][0] + bs), bfhi(ur.x) * (acc[cb][1] + bs)); o.y = pk2(bflo(ur.y) * (acc[cb][2] + bs), bfhi(ur.y) * (acc[cb][3] + bs));
            *(u32x2*)(P.YB + off) = o; }
    }
    __syncthreads();
}
__device__ __forceinline__ void mix_phase(const Frame& F, const MixP& P) {
    for (int it = blockIdx.x; it < 64 + 512 + 512; it += F.G) {
        if (it < 64) kmean_item(F, P, it);
        else if (it < 576) conv_item(F, P, it - 64);
        else sgu_item(F, P, it - 576);
    }
}
}

#ifndef PHM
#define PHM 0xFFFF
#endif
struct Args { const float* in[21]; float* out; unsigned char* ws; };
typedef __attribute__((address_space(4))) const unsigned char* kargp_t;
__device__ __forceinline__ const float* ldarg(int i) {
#if defined(__HIP_DEVICE_COMPILE__)
    kargp_t p = (kargp_t)__builtin_amdgcn_kernarg_segment_ptr(); asm volatile("" : "+s"(p)); return (const float*)*(__attribute__((address_space(4))) const unsigned long long*)(p + 8 * i);
#else
    return nullptr;
#endif
}
#define INP(i) ldarg(i)
#define OUTP() ((float*)ldarg(21))
#define WSB(off) ((mk::bf16*)((unsigned char*)ldarg(22) + (off)))
#define WSF(off) ((float*)((unsigned char*)ldarg(22) + (off)))
__global__ void __launch_bounds__(512, 2) mk_fwd(Args a) {
    using namespace mk;
    extern __shared__ __attribute__((aligned(16))) unsigned char lds[];
    cg::grid_group grid = cg::this_grid();
    Frame F; F.lds = lds; F.tid = threadIdx.x; F.lane = F.tid & 63; F.wave = __builtin_amdgcn_readfirstlane(F.tid >> 6); F.G = gridDim.x;
    F.gw = blockIdx.x * NWV + F.wave; F.ngw = F.G * NWV;
    PG8_LAS unsigned char* ldsA = (PG8_LAS unsigned char*)lds;

    if constexpr (PHM & 1) rope_tables(F, WSF(WS_ROPE));
#pragma unroll 1
    for (int l = 0; l < NLAYER; ++l) {
#pragma unroll 1
        for (int f = 0; f < 2; ++f) {
            const bool first = (l == 0 && f == 0);
            frame_refresh(F);
            if constexpr (PHM & 2) { if (f == 0) {
                cvt_weight(F, INP(2) + (size_t)l * DM * 2 * FF, DM, 2 * FF, WSB(WS_WFI), 1);
                cvt_weight(F, INP(3) + (size_t)l * FF * DM, FF, DM, WSB(WS_WFO), 0);
            }
            if ((f == 0 && l == 0) || (f == 1 && l + 1 < NLAYER)) {
                const int lm = (f == 0) ? 0 : l + 1;
                cvt_weight(F, INP(5) + (size_t)lm * DM * NIN, DM, NIN, WSB(WS_WIN), 2);
#pragma unroll 1
                for (int i = 0; i < 3; ++i) cvt_weight(F, INP(14) + ((size_t)lm * 3 + i) * CW * DM, CW, DM, WSB(WS_WBR) + (size_t)i * DM * CW, 0);
                cvt_weight(F, INP(16) + (size_t)lm * DM * DM, DM, DM, WSB(WS_WOUT), 0);
            } }
            if constexpr (PHM & 4) norm_rows(F, first ? INP(0) : (const float*)OUTP(), (f ? INP(17) : INP(1)) + l * DM, WSB(WS_XN));
            grid.sync();
            if constexpr (PHM & 8) { pg8::Gemm g{WSB(WS_XN), WSB(WS_WFI), TOK, 2 * FF, DM}; pg8::StaticOrder S; S.init(TOK, 2 * FF, F.G, (int)blockIdx.x); EpiSwiGLU E{WSB(WS_ACT), FF};
              pg8::gemm_phase<EpiSwiGLU, pg8::StaticOrder, true, true>(ldsA, g, S, E); }
            grid.sync();
            if constexpr (PHM & 16) { pg8::Gemm g{WSB(WS_ACT), WSB(WS_WFO), TOK, DM, FF}; pg8::StaticOrder S; S.init(TOK, DM, F.G, (int)blockIdx.x); EpiResid E{first ? INP(0) : (const float*)OUTP(), OUTP(), 0.5f};
              pg8::gemm_phase<EpiResid, pg8::StaticOrder, true, true>(ldsA, g, S, E); }
            grid.sync();
            if (f == 0) {
                frame_refresh(F);
                if constexpr (PHM & 2) { cvt_weight(F, INP(18) + (size_t)l * DM * 2 * FF, DM, 2 * FF, WSB(WS_WFI), 1);
                cvt_weight(F, INP(19) + (size_t)l * FF * DM, FF, DM, WSB(WS_WFO), 0); }
                if constexpr (PHM & 4) norm_rows(F, OUTP(), INP(4) + l * DM, WSB(WS_XN));
                grid.sync();
                if constexpr (PHM & 32) { pg8::Gemm g{WSB(WS_XN), WSB(WS_WIN), TOK, NIN, DM}; pg8::StaticOrder S; S.init(TOK, NIN, F.G, (int)blockIdx.x);
                  EpiWin E{WSB(WS_GLU), WSB(WS_U), WSB(WS_SV), WSB(WS_Q), WSB(WS_K), WSB(WS_V), WSB(WS_GATES), INP(15) + l * 3 * DM, WSF(WS_ROPE)};
                  pg8::gemm_phase<EpiWin, pg8::StaticOrder, true, true>(ldsA, g, S, E); }
                grid.sync();
                frame_refresh(F);
                if constexpr (PHM & 64) { MixP P{WSB(WS_GLU), WSB(WS_U), WSB(WS_SV), WSB(WS_K), WSB(WS_YA), WSB(WS_YB), WSF(WS_KMEAN), INP(6) + l * 31 * CW, INP(7) + l * CW, INP(8) + l * CW, INP(9) + l * CW, INP(10) + l * CW, INP(11) + l * CW, INP(12) + (size_t)l * 4 * 128 * 128, INP(13) + l * 4 * 128};
                  mix_phase(F, P); }
                grid.sync();
                if constexpr (PHM & 128) { const attn_body::AttnTensors AT{(const attn_body::bf16*)WSB(WS_Q), (const attn_body::bf16*)WSB(WS_K), (const attn_body::bf16*)WSB(WS_V), (attn_body::bf16*)WSB(WS_Q), WSF(WS_KMEAN)};
                  const attn_body::StaticOrder S((int)F.G, (int)blockIdx.x);
                  attn_body::attn_phase<attn_body::StaticOrder>((char*)lds, AT, S); }
                grid.sync();
                if constexpr (PHM & 256) { pg8::Gemm g{WSB(WS_YA), WSB(WS_WBR), 3 * TOK, 3 * DM, CW}; BranchOrder S; S.base.init(TOK, DM, F.G, (int)blockIdx.x); EpiBranch E{WSB(WS_GATES), WSB(WS_MERGED)};
                  pg8::gemm_phase<EpiBranch, BranchOrder, true, true>(ldsA, g, S, E); }
                grid.sync();
                if constexpr (PHM & 512) { pg8::Gemm g{WSB(WS_MERGED), WSB(WS_WOUT), TOK, DM, DM}; pg8::StaticOrder S; S.init(TOK, DM, F.G, (int)blockIdx.x); EpiResid E{OUTP(), OUTP(), 1.0f};
                  pg8::gemm_phase<EpiResid, pg8::StaticOrder, true, true>(ldsA, g, S, E); }
                grid.sync();
            }
        }
    }
    frame_refresh(F);
    if constexpr (PHM & 1024) final_norm_rows(F, OUTP(), INP(20));
}

extern "C" void kernel_launch(void* const* d_in, const int* in_sizes, int n_in, void* d_out, int out_size, void* d_ws, size_t ws_size, hipStream_t stream) {
    static int grid = 0;
    if (grid == 0) {
        if (n_in != 21 || out_size != mk::TOK * mk::DM || ws_size < mk::WS_END) { fprintf(stderr, "kernel_launch: unexpected shapes (n_in %d out %d ws %zu)\n", n_in, out_size, ws_size); grid = -1; return; }
        int dev = 0, cus = 0, per_cu = 0;
        hipGetDevice(&dev); hipDeviceGetAttribute(&cus, hipDeviceAttributeMultiprocessorCount, dev);
        if (hipFuncSetAttribute((const void*)mk_fwd, hipFuncAttributeMaxDynamicSharedMemorySize, mk::LDS_BYTES) != hipSuccess) { fprintf(stderr, "kernel_launch: hipFuncSetAttribute failed\n"); grid = -1; return; }
        if (hipOccupancyMaxActiveBlocksPerMultiprocessor(&per_cu, (const void*)mk_fwd, mk::NTHR, mk::LDS_BYTES) != hipSuccess || per_cu < 1) { fprintf(stderr, "kernel_launch: occupancy query failed (%d)\n", per_cu); grid = -1; return; }
        grid = cus * (per_cu > 1 ? 1 : per_cu);
    }
    if (grid < 0) return;
    Args a{};
    for (int i = 0; i < 21; ++i) a.in[i] = (const float*)d_in[i];
    a.out = (float*)d_out; a.ws = (unsigned char*)d_ws;
    void* args[] = {&a};
    hipError_t e = hipLaunchCooperativeKernel((const void*)mk_fwd, dim3(grid), dim3(mk::NTHR), args, mk::LDS_BYTES, stream);
    if (e != hipSuccess) fprintf(stderr, "cooperative launch failed: %s (grid %d)\n", hipGetErrorString(e), grid);
}
```

```cpp
#include <hip/hip_runtime.h>
#include <hip/hip_cooperative_groups.h>
#include <hip/hip_bf16.h>
#include <cstdio>
#include <cstdint>
#include <cmath>
namespace cg = cooperative_groups;

namespace pg8 {
#define PG8_LAS __attribute__((address_space(3)))
typedef unsigned short bf16_t;
typedef short bf16x8 __attribute__((ext_vector_type(8)));
typedef float f32x4 __attribute__((ext_vector_type(4)));
typedef unsigned u32x4 __attribute__((ext_vector_type(4)));
constexpr int BM = 256, BK = 64, HALF = 128, HTB = HALF * BK * 2  , STAGE_BYTES = 8 * HTB, NXCD = 8, WGM = 4;

__host__ __device__ __forceinline__ int lds_byte(int r, int c) { const int st = (r >> 4) * 2 + (c >> 5), rr = r & 15, cc = c & 31, ob = rr * 64 + cc * 2; return st * 1024 + (ob ^ (((ob >> 9) & 1) << 5)); }
__host__ __device__ __forceinline__ void stage_rc(int b, int& R, int& C) { const int st = b / 1024, sb = b % 1024, swz = sb ^ (((sb >> 9) & 1) << 5); R = (st >> 1) * 16 + swz / 64; C = (st & 1) * 32 + (swz % 64) / 2; }
__host__ __device__ __forceinline__ int perm32(int rho) { const int n = rho >> 4, i = rho & 15; return 8 * (i >> 2) + 4 * n + (i & 3); }

struct Unit { int pm, pn; };
struct Gemm { const bf16_t* A; const bf16_t* Bt; int M, N, K; };

struct StaticOrder {
    int nM, nN, nwg, G, c;
    __host__ __device__ void init(int M, int N, int G_, int c_) { nM = M / BM; nN = N / BM; nwg = nM * nN; G = G_; c = c_; }
    __host__ __device__ bool next(int i, Unit& u) const {
        const long L = (long)i * G + c; if (L >= nwg) return false;
        int wgid = (int)L; { const int q = nwg / NXCD, r = nwg % NXCD, xcd = wgid % NXCD, off = wgid / NXCD; wgid = (xcd < r ? xcd * (q + 1) : r * (q + 1) + (xcd - r) * q) + off; }
        const int nig = WGM * nN, gid = wgid / nig, fm = gid * WGM, gsz = (nM - fm) < WGM ? (nM - fm) : WGM;
        u.pm = fm + ((wgid % nig) % gsz); u.pn = (wgid % nig) / gsz; return true;
    }
    __device__ __forceinline__ void a_ready(const Unit&) const {}
    __device__ __forceinline__ void done(const Unit&) const {}
};

__device__ __forceinline__ unsigned cvt_pk_bf16(float lo, float hi) { unsigned r; asm volatile("v_cvt_pk_bf16_f32 %0, %1, %2" : "=v"(r) : "v"(lo), "v"(hi)); return r; }
typedef float f32x2 __attribute__((ext_vector_type(2)));
template <class Epi, class Sched, bool ALIGN_EPI = false, bool SP2 = false>
__device__ __forceinline__ void gemm_phase(PG8_LAS unsigned char* lds, const Gemm g, const Sched& S, const Epi& E) {
    int tid_ = threadIdx.x; asm volatile("" : "+v"(tid_));
    const int tid = tid_, wid = __builtin_amdgcn_readfirstlane(tid >> 6), lane = tid & 63, wr = wid >> 2, wc = wid & 3, fr = lane & 15, fq = lane >> 4;
    const int K = g.K, nt = K / BK;
    unsigned voffA[2], voffB[2];
#pragma unroll
    for (int i = 0; i < 2; ++i) { int R, C; stage_rc(tid * 16 + i * 8192, R, C); const int Rb = Epi::PERM ? ((R & ~31) + perm32(R & 31)) : R;
        voffA[i] = (unsigned)(R * K + C) * 2u; voffB[i] = (unsigned)(Rb * K + C) * 2u; }
    const size_t kstep = (size_t)(BK * 2);
    const size_t hstep = (size_t)HALF * K * 2;
    const size_t tstep = 2 * hstep;
    const unsigned ldsw = (unsigned)wid * 1024u;
    const int aoff = lds_byte(wr * 64 + fr, fq * 8), boff = lds_byte(wc * 32 + fr, fq * 8);
#define PG8_SA(b, h) (((b) * 2 + (h)) * HTB)
#define PG8_SB(b, h) ((4 + (b) * 2 + (h)) * HTB)
#define PG8_STAGE(bufoff, gbase, voff) do { _Pragma("unroll") for (int _i = 0; _i < 2; ++_i) \
        __builtin_amdgcn_global_load_lds((const unsigned*)((const char*)(gbase) + (voff)[_i]), (PG8_LAS unsigned*)(lds + (bufoff) + ldsw + _i * 8192), 16, 0, 0); } while (0)
#define PG8_LDA(dst, b, h) do { _Pragma("unroll") for (int m = 0; m < 4; ++m) _Pragma("unroll") for (int k = 0; k < 2; ++k) dst[m][k] = *(const PG8_LAS bf16x8*)(lds + PG8_SA(b, h) + aoff + m * 2048 + k * 1024); } while (0)
#define PG8_LDB(dst, b, h) do { _Pragma("unroll") for (int n = 0; n < 2; ++n) _Pragma("unroll") for (int k = 0; k < 2; ++k) dst[n][k] = *(const PG8_LAS bf16x8*)(lds + PG8_SB(b, h) + boff + n * 2048 + k * 1024); } while (0)
#define PG8_MMA(ai, bj, At, Bt) do { __builtin_amdgcn_s_setprio(1); _Pragma("unroll") for (int m = 0; m < 4; ++m) _Pragma("unroll") for (int n = 0; n < 2; ++n) _Pragma("unroll") for (int k = 0; k < 2; ++k) \
        acc[ai][bj][m][n] = __builtin_amdgcn_mfma_f32_16x16x32_bf16(Bt[n][k], At[m][k], acc[ai][bj][m][n], 0, 0, 0); __builtin_amdgcn_s_setprio(0); } while (0)
#define PG8_WAIT_V(n) asm volatile("s_waitcnt vmcnt(" #n ")" ::: "memory")
#define PG8_WAIT_L(n) asm volatile("s_waitcnt lgkmcnt(" #n ")" ::: "memory")
#define PG8_BAR __builtin_amdgcn_s_barrier()
#define PG8_SCHED __builtin_amdgcn_sched_barrier(0)
    Unit cur, nxt; int ui = 0;
    if (!S.next(0, cur)) return;
    f32x4 acc[2][2][4][2];
#pragma unroll
    for (int a = 0; a < 2; ++a)
#pragma unroll
        for (int b = 0; b < 2; ++b)
#pragma unroll
            for (int m = 0; m < 4; ++m)
#pragma unroll
                for (int n = 0; n < 2; ++n) acc[a][b][m][n] = (f32x4){0.f, 0.f, 0.f, 0.f};
    bf16x8 At[4][2], B0[2][2], B1[2][2];
    const char* cA = (const char*)g.A + (size_t)cur.pm * tstep; const char* cB = (const char*)g.Bt + (size_t)cur.pn * tstep;
    S.a_ready(cur);
    if constexpr (SP2) {
        PG8_STAGE(PG8_SB(0, 0), cB, voffB); PG8_STAGE(PG8_SB(0, 1), cB + hstep, voffB); PG8_STAGE(PG8_SA(0, 0), cA, voffA); PG8_STAGE(PG8_SA(0, 1), cA + hstep, voffA);
        if (wr == 1) PG8_BAR;
        PG8_WAIT_V(2); PG8_BAR;
        PG8_STAGE(PG8_SB(1, 0), cB + kstep, voffB); PG8_STAGE(PG8_SA(1, 0), cA + kstep, voffA); PG8_STAGE(PG8_SB(1, 1), cB + hstep + kstep, voffB);
        PG8_WAIT_V(6); PG8_BAR;
    } else {
        PG8_STAGE(PG8_SB(0, 0), cB, voffB); PG8_STAGE(PG8_SA(0, 0), cA, voffA); PG8_STAGE(PG8_SB(0, 1), cB + hstep, voffB); PG8_STAGE(PG8_SA(0, 1), cA + hstep, voffA);
        if (wr == 1) PG8_BAR;
        PG8_WAIT_V(4); PG8_BAR;
        PG8_STAGE(PG8_SB(1, 0), cB + kstep, voffB); PG8_STAGE(PG8_SA(1, 0), cA + kstep, voffA); PG8_STAGE(PG8_SB(1, 1), cB + hstep + kstep, voffB);
        PG8_WAIT_V(6); PG8_BAR;
    }
    for (;;) {
        const bool has_next = S.next(ui + 1, nxt);
        const char* nA = has_next ? (const char*)g.A + (size_t)nxt.pm * tstep : cA; const char* nB = has_next ? (const char*)g.Bt + (size_t)nxt.pn * tstep : cB;
        for (int t = 0; t < nt; t += 2) {
            const bool last = (t == nt - 2);
            const char* a1 = cA + (size_t)(t + 1) * kstep;
            const char* a2 = last ? nA : cA + (size_t)(t + 2) * kstep; const char* b2 = last ? nB : cB + (size_t)(t + 2) * kstep;
            const char* a3 = a2 + kstep; const char* b3 = b2 + kstep;
            if (last && has_next) S.a_ready(nxt);
            if constexpr (SP2) {
            PG8_LDB(B0, 0, 0); PG8_LDB(B1, 0, 1); PG8_SCHED; PG8_LDA(At, 0, 0); PG8_STAGE(PG8_SA(1, 1), a1 + hstep, voffA);
            PG8_WAIT_V(8); PG8_WAIT_L(0); PG8_BAR; PG8_MMA(0, 0, At, B0); PG8_MMA(0, 1, At, B1); PG8_BAR; PG8_SCHED;
            PG8_LDA(At, 0, 1); PG8_STAGE(PG8_SB(0, 0), b2, voffB); PG8_STAGE(PG8_SB(0, 1), b2 + hstep, voffB); PG8_STAGE(PG8_SA(0, 0), a2, voffA);
            PG8_WAIT_V(8); PG8_WAIT_L(0); PG8_BAR; PG8_MMA(1, 0, At, B0); PG8_MMA(1, 1, At, B1); PG8_BAR; PG8_SCHED;
            PG8_LDB(B0, 1, 0); PG8_LDB(B1, 1, 1); PG8_SCHED; PG8_LDA(At, 1, 0); PG8_STAGE(PG8_SA(0, 1), a2 + hstep, voffA);
            PG8_WAIT_V(8); PG8_WAIT_L(0); PG8_BAR; PG8_MMA(0, 0, At, B0); PG8_MMA(0, 1, At, B1); PG8_BAR; PG8_SCHED;
            PG8_LDA(At, 1, 1); PG8_STAGE(PG8_SB(1, 0), b3, voffB); PG8_STAGE(PG8_SB(1, 1), b3 + hstep, voffB); PG8_STAGE(PG8_SA(1, 0), a3, voffA);
            PG8_WAIT_V(8); PG8_WAIT_L(0); PG8_BAR; PG8_MMA(1, 0, At, B0); PG8_MMA(1, 1, At, B1); PG8_BAR; PG8_SCHED;
            } else {
            PG8_LDB(B0, 0, 0); PG8_SCHED; PG8_LDA(At, 0, 0); PG8_STAGE(PG8_SA(1, 1), a1 + hstep, voffA);
            PG8_WAIT_L(8); PG8_BAR; PG8_WAIT_L(0); PG8_MMA(0, 0, At, B0); PG8_BAR; PG8_SCHED;
            PG8_LDB(B1, 0, 1); PG8_STAGE(PG8_SB(0, 0), b2, voffB);
            PG8_BAR; PG8_WAIT_L(0); PG8_MMA(0, 1, At, B1); PG8_BAR;
            PG8_LDA(At, 0, 1); PG8_STAGE(PG8_SA(0, 0), a2, voffA);
            PG8_BAR; PG8_WAIT_L(0); PG8_MMA(1, 0, At, B0); PG8_BAR; PG8_SCHED;
            PG8_STAGE(PG8_SB(0, 1), b2 + hstep, voffB);
            PG8_WAIT_V(6); PG8_BAR; PG8_MMA(1, 1, At, B1); PG8_BAR;
            PG8_LDB(B0, 1, 0); PG8_SCHED; PG8_LDA(At, 1, 0); PG8_STAGE(PG8_SA(0, 1), a2 + hstep, voffA);
            PG8_WAIT_L(8); PG8_BAR; PG8_WAIT_L(0); PG8_MMA(0, 0, At, B0); PG8_BAR; PG8_SCHED;
            PG8_LDB(B1, 1, 1); PG8_STAGE(PG8_SB(1, 0), b3, voffB);
            PG8_BAR; PG8_WAIT_L(0); PG8_MMA(0, 1, At, B1); PG8_BAR;
            PG8_LDA(At, 1, 1); PG8_STAGE(PG8_SA(1, 0), a3, voffA);
            PG8_BAR; PG8_WAIT_L(0); PG8_MMA(1, 0, At, B0); PG8_BAR; PG8_SCHED;
            PG8_STAGE(PG8_SB(1, 1), b3 + hstep, voffB);
            PG8_WAIT_V(6); PG8_BAR; PG8_MMA(1, 1, At, B1); PG8_BAR;
            }
        }
        if constexpr (ALIGN_EPI) { if (wr == 0) PG8_BAR; }
        if constexpr (!Epi::AFTER_DRAIN) { if constexpr (Epi::KEEP_ACC) E.inplace(acc, cur, wr, wc, fr, fq); else E(acc, cur, wr, wc, fr, fq);
#ifdef DUP_EPI
            if constexpr (Epi::DUP) { asm volatile("" ::: "memory"); --E.ui; E(acc, cur, wr, wc, fr, fq); }
#endif
            S.done(cur); }
        if (!has_next) break;
        bool keep_ = false; if constexpr (Epi::KEEP_ACC) keep_ = E.keep(cur);
        if (!keep_) {
#pragma unroll
        for (int a = 0; a < 2; ++a)
#pragma unroll
            for (int b = 0; b < 2; ++b)
#pragma unroll
                for (int m = 0; m < 4; ++m)
#pragma unroll
                    for (int n = 0; n < 2; ++n) acc[a][b][m][n] = (f32x4){0.f, 0.f, 0.f, 0.f};
        }
        cur = nxt; cA = nA; cB = nB; ++ui;
        if constexpr (ALIGN_EPI) { if (wr == 1) PG8_BAR; }
    }
    PG8_WAIT_V(0);
    if constexpr (!ALIGN_EPI) { if (wr == 0) PG8_BAR; }
    PG8_BAR;
    if constexpr (Epi::AFTER_DRAIN) { E.fused(acc, cur, wr, wc, fr, fq, lds, wid, lane); S.done(cur); }
#undef PG8_SA
#undef PG8_SB
#undef PG8_STAGE
#undef PG8_LDA
#undef PG8_LDB
#undef PG8_MMA
#undef PG8_WAIT_V
#undef PG8_WAIT_L
#undef PG8_BAR
#undef PG8_SCHED
}
}
namespace attn_body {
using bf16=__hip_bfloat16;
using bf16x8=__attribute__((ext_vector_type(8)))short;
using s16x4=__attribute__((ext_vector_type(4)))short;
using f32x16=__attribute__((ext_vector_type(16)))float;
using u32x4=__attribute__((ext_vector_type(4)))unsigned;
constexpr int BATCH=2,NHEAD=8,SEQ=8192,D=64,DM=NHEAD*D;
constexpr int NW=8,QBLK=32,QB=QBLK*NW,KVBLK=64,NQB=SEQ/QB;
constexpr int ATTN_PITCH=DM, ATTN_UNIT_ROWS=QB;
__device__ __forceinline__ int crow(int r,int hi){return (r&3)+8*(r>>2)+4*hi;}
#define SBAR() __builtin_amdgcn_sched_barrier(0)
__device__ __forceinline__ void cmask(f32x16&p0,f32x16&p1,int jb,int qrel,int hi){
  const float NEG=-INFINITY; int kb=64*jb+4*hi;
  #pragma unroll
  for(int r=0;r<16;++r){int kv=kb+(r&3)+8*(r>>2); if(kv>qrel)p0[r]=NEG; if(kv+32>qrel)p1[r]=NEG;}
}

constexpr int NSLOT=3, SLOTB=8192;
constexpr int LDS_K=0, LDS_V=NSLOT*SLOTB, LDS_WS=2*NSLOT*SLOTB, LDS_OST=LDS_WS+NW*64*4, LDS_KM=LDS_OST+NW*4096, LDS_BYTES=LDS_KM+32*64*4;
constexpr float C2=0.125f*1.4426950408889634f;
__device__ __forceinline__ void glds16(const void*gsrc,unsigned lds_dst){unsigned keep;
  asm volatile("s_mov_b32 %0, m0\n\ts_mov_b32 m0, %2\n\ts_nop 0\n\tglobal_load_lds_dwordx4 %1, off\n\ts_mov_b32 m0, %0":"=&s"(keep):"v"(gsrc),"s"(lds_dst):"memory");}
__device__ __forceinline__ float max3f(float a,float b,float c){float r;asm("v_max3_f32 %0, %1, %2, %3":"=v"(r):"v"(a),"v"(b),"v"(c));return r;}
__device__ __forceinline__ float max2f(float a,float b){float r;asm("v_max_f32_e32 %0, %1, %2":"=v"(r):"v"(a),"v"(b));return r;}
__device__ __forceinline__ float fadd_s(float a,float b){float r;asm("v_add_f32_e32 %0, %1, %2":"=v"(r):"v"(a),"v"(b));return r;}
__device__ __forceinline__ float fsub_s(float a,float b){float r;asm("v_sub_f32_e32 %0, %1, %2":"=v"(r):"v"(a),"v"(b));return r;}
typedef float f32x2_t __attribute__((ext_vector_type(2))); typedef __bf16 bf16x2_t __attribute__((ext_vector_type(2)));
__device__ __forceinline__ unsigned cvtpk_s(float lo,float hi){f32x2_t v={lo,hi};bf16x2_t b=__builtin_convertvector(v,bf16x2_t);return __builtin_bit_cast(unsigned,b);}
#define WAIT_BAR(N) asm volatile("s_waitcnt vmcnt(" #N ") lgkmcnt(0)\n\ts_barrier":::"memory")

__device__ __forceinline__ void qkt(f32x16&p0,f32x16&p1,const char*Kslot,const bf16x8*qr,const f32x16&negm,int r32,int hi){
  const char*kb=Kslot+hi*1024+r32*16;
  #pragma unroll
  for(int d0=0;d0<4;++d0){
    const bf16x8 b0=*reinterpret_cast<const bf16x8*>(kb+d0*2048);
    const bf16x8 b1=*reinterpret_cast<const bf16x8*>(kb+d0*2048+512);
    if(d0==0){p0=__builtin_amdgcn_mfma_f32_32x32x16_bf16(b0,qr[0],negm,0,0,0);p1=__builtin_amdgcn_mfma_f32_32x32x16_bf16(b1,qr[0],negm,0,0,0);}
    else{p0=__builtin_amdgcn_mfma_f32_32x32x16_bf16(b0,qr[d0],p0,0,0,0);p1=__builtin_amdgcn_mfma_f32_32x32x16_bf16(b1,qr[d0],p1,0,0,0);}}
}
typedef __attribute__((address_space(3))) const char* lds_cptr;
typedef short v4i16_t __attribute__((ext_vector_type(4)));
__device__ __forceinline__ void kload8(bf16x8*kf,lds_cptr kp){
  kf[0]=*(const __attribute__((address_space(3))) bf16x8*)(kp);      kf[1]=*(const __attribute__((address_space(3))) bf16x8*)(kp+512);
  kf[2]=*(const __attribute__((address_space(3))) bf16x8*)(kp+2048); kf[3]=*(const __attribute__((address_space(3))) bf16x8*)(kp+2560);
  kf[4]=*(const __attribute__((address_space(3))) bf16x8*)(kp+4096); kf[5]=*(const __attribute__((address_space(3))) bf16x8*)(kp+4608);
  kf[6]=*(const __attribute__((address_space(3))) bf16x8*)(kp+6144); kf[7]=*(const __attribute__((address_space(3))) bf16x8*)(kp+6656);
}
__device__ __forceinline__ void kload2(bf16x8*kf,lds_cptr kp,int j){ kf[2*j]=*(const __attribute__((address_space(3))) bf16x8*)(kp+j*2048); kf[2*j+1]=*(const __attribute__((address_space(3))) bf16x8*)(kp+j*2048+512); }
__device__ __forceinline__ s16x4 vtr(lds_cptr p){ return __builtin_bit_cast(s16x4,__builtin_amdgcn_ds_read_tr16_b64_v4i16((__attribute__((address_space(3))) v4i16_t*)p)); }
__device__ __forceinline__ float rowmax(const f32x16&p0,const f32x16&p1){
  float a=max3f(p0[0],p0[1],p1[0]),b=max3f(p0[2],p0[3],p1[1]);a=max3f(a,p1[2],p1[3]);
  #pragma unroll
  for(int r=4;r<16;r+=4){a=max3f(a,p0[r],p0[r+1]);b=max3f(b,p0[r+2],p0[r+3]);a=max3f(a,p1[r],p1[r+1]);b=max3f(b,p1[r+2],p1[r+3]);}
  const float m=max2f(a,b);
  auto rr=__builtin_amdgcn_permlane32_swap(__float_as_uint(m),__float_as_uint(m),false,false);
  return max2f(__uint_as_float(rr[0]),__uint_as_float(rr[1]));
}
__device__ __forceinline__ void pv(f32x16*o,int vb,bf16x8 pa0,bf16x8 pa1,bf16x8 pa2,bf16x8 pa3){
  #pragma unroll
  for(int d0=0;d0<2;++d0){s16x4 lo[4],hi[4];
    #pragma unroll
    for(int ks=0;ks<4;++ks){
      asm volatile("ds_read_b64_tr_b16 %0,%1 offset:%c2":"=&v"(lo[ks]):"v"(vb),"i"(d0*4096+ks*1024):"memory");
      asm volatile("ds_read_b64_tr_b16 %0,%1 offset:%c2":"=&v"(hi[ks]):"v"(vb),"i"(d0*4096+ks*1024+512):"memory");}
    asm volatile("s_waitcnt lgkmcnt(0)":::"memory");SBAR();
    #define PK(k) (bf16x8){lo[k][0],lo[k][1],lo[k][2],lo[k][3],hi[k][0],hi[k][1],hi[k][2],hi[k][3]}
    o[d0]=__builtin_amdgcn_mfma_f32_32x32x16_bf16(pa0,PK(0),o[d0],0,0,0);
    o[d0]=__builtin_amdgcn_mfma_f32_32x32x16_bf16(pa1,PK(1),o[d0],0,0,0);
    o[d0]=__builtin_amdgcn_mfma_f32_32x32x16_bf16(pa2,PK(2),o[d0],0,0,0);
    o[d0]=__builtin_amdgcn_mfma_f32_32x32x16_bf16(pa3,PK(3),o[d0],0,0,0);
    #undef PK
  }
}

#ifndef ATTN_STORE16
#define ATTN_STORE16(p,v) (*(u32x4*)(p)=(v))
#endif
template<int THRL> __device__ __forceinline__ void attn_unit(int b,int h,int qb,const bf16*Q,const bf16*__restrict__ K,const bf16*__restrict__ V,bf16*O,const float*__restrict__ KMG,char*shm,const bool load_km){
  int tid_=threadIdx.x; asm volatile("":"+v"(tid_)); const int tid=tid_,lane=tid&63,r32=lane&31,hi=lane>>5; const int wid=__builtin_amdgcn_readfirstlane(tid>>6);
  const long rowbase=(long)b*SEQ; const int q0=qb*QB;
  const bf16*Qw=Q+(rowbase+q0+wid*QBLK)*DM+h*D;
  const bf16*Kh=K+rowbase*DM+h*D,*Vh=V+rowbase*DM+h*D;
  const unsigned lds0=(unsigned)(uintptr_t)shm;
  float*wsf=(float*)(shm+LDS_WS)+wid*64;
  const bf16*ksrc=Kh+(long)lane*DM+wid*8;
  const bf16*vsrc=Vh+(long)(16*(wid&3)+(lane>>2))*DM+(wid>>2)*32+(lane&3)*8;
  const unsigned kdst=lds0+LDS_K+wid*1024, vdst=lds0+LDS_V+wid*1024;
  #define TILE(p) (((p)<4)?(NT-4+(p)):((p)-4))
  #define DMA_K(t,slot) glds16(ksrc+(long)TILE(t)*KVBLK*DM,(unsigned)__builtin_amdgcn_readfirstlane(kdst+(slot)))
  #define DMA_V(t,slot) glds16(vsrc+(long)TILE(t)*KVBLK*DM,(unsigned)__builtin_amdgcn_readfirstlane(vdst+(slot)))
  const int vb0=(int)(lds0+LDS_V)+((lane>>4)&1)*32+(lane&3)*8+(4*hi+((lane&15)>>2))*64;
  const char*Kbase=shm+LDS_K; bf16x8 kf[8];
  const lds_cptr shm3=(lds_cptr)shm; const lds_cptr kp0=shm3+LDS_K+hi*1024+r32*16; const lds_cptr vp0=shm3+LDS_V+((lane>>4)&1)*32+(lane&3)*8+(4*hi+((lane&15)>>2))*64;
  const int NT=(q0+QB)/KVBLK;
  if(load_km){ float*kml=(float*)(shm+LDS_KM); const int idx=tid*4; const int blk=idx>>6,dd=idx&63; const float*kp=KMG+((long)(b*32+blk)*16*DM+h*D+dd);
    float4 s4=*(const float4*)kp;
    #pragma unroll
    for(int p=1;p<16;++p){const float4 v4=*(const float4*)(kp+(long)p*DM); s4.x+=v4.x;s4.y+=v4.y;s4.z+=v4.z;s4.w+=v4.w;}
    s4.x*=(1.f/256.f);s4.y*=(1.f/256.f);s4.z*=(1.f/256.f);s4.w*=(1.f/256.f);
    *(float4*)(kml+idx)=s4; }
  DMA_K(0,0);DMA_V(0,0);DMA_K(1,SLOTB);
  bf16x8 qr[4];
  #pragma unroll
  for(int d0=0;d0<4;++d0)qr[d0]=*reinterpret_cast<const bf16x8*>(&Qw[(long)r32*DM+d0*16+hi*8]);
  __syncthreads();
  unsigned selm=0u;
  if(qb>0){
    float qf[32];
    #pragma unroll
    for(int d0=0;d0<4;++d0){
      #pragma unroll
      for(int e=0;e<8;++e)qf[d0*8+e]=__uint_as_float(((unsigned)(unsigned short)qr[d0][e])<<16);}
    float b0=-INFINITY,b1=-INFINITY,b2=-INFINITY; int i0=-1,i1=-1,i2=-1;
    const float*kml=(const float*)(shm+LDS_KM)+hi*8;
    for(int j=0;j<qb;++j){
      float g=0.f;
      #pragma unroll
      for(int d0=0;d0<4;++d0){
        const float4 ka=*(const float4*)(kml+j*64+d0*16),kb4=*(const float4*)(kml+j*64+d0*16+4);
        g+=qf[d0*8+0]*ka.x+qf[d0*8+1]*ka.y+qf[d0*8+2]*ka.z+qf[d0*8+3]*ka.w+qf[d0*8+4]*kb4.x+qf[d0*8+5]*kb4.y+qf[d0*8+6]*kb4.z+qf[d0*8+7]*kb4.w;}
      g+=__shfl_xor(g,32);
      if(g>b0){b2=b1;i2=i1;b1=b0;i1=i0;b0=g;i0=j;}
      else if(g>b1){b2=b1;i2=i1;b1=g;i1=j;}
      else if(g>b2){b2=g;i2=j;}
    }
    if(i0>=0)selm|=1u<<i0; if(i1>=0)selm|=1u<<i1; if(i2>=0)selm|=1u<<i2;
  }
  float mhat=0.f,l_reg=0.f;f32x16 o[2];o[0]=f32x16{};o[1]=f32x16{};const f32x16 zero16=f32x16{};
  const int qrel=wid*QBLK+r32;
  #define CMASK_ROW(P0,P1,t) do{ const float pen_=((selm>>((((t)-4)>>2)&31))&1u)?-mhat:-INFINITY; _Pragma("unroll") for(int r_=0;r_<16;++r_){P0[r_]+=pen_;P1[r_]+=pen_;} }while(0)
  #define CMASK_FULL(P0,P1,t) do{ if((t)<4){ const float nm_=-mhat; _Pragma("unroll") for(int r_=0;r_<16;++r_){P0[r_]+=nm_;P1[r_]+=nm_;} cmask(P0,P1,(t),qrel,hi);} else CMASK_ROW(P0,P1,t); }while(0)
  #define CMASK(P0,P1,t) CMASK_FULL(P0,P1,t)
  bool resc=false;
  #define START(P0,P1) do{ const float rm=rowmax(P0,P1); resc=false; \
    { const float dl=rm; mhat=fadd_s(mhat,dl); \
      _Pragma("unroll") for(int r=0;r<16;++r){P0[r]=fsub_s(P0[r],dl);P1[r]=fsub_s(P1[r],dl);} \
      } \
    _Pragma("unroll") for(int r=0;r<16;++r)P0[r]=__builtin_amdgcn_exp2f(P0[r]); }while(0)
  #define RESC() do{ if(resc){ asm volatile("s_waitcnt lgkmcnt(0)":::"memory"); \
      _Pragma("unroll") for(int d_=0;d_<2;++d_) _Pragma("unroll") for(int r=0;r<16;++r)o[d_][r]*=wsf[crow(r,hi)]; } }while(0)
  f32x16 pA0,pA1,pB0,pB1;
  int sl_prev=0,sl_cur=0,sl_next=SLOTB;
  #define ROT() do{sl_prev=sl_cur;sl_cur=sl_next;sl_next=(sl_next==(NSLOT-1)*SLOTB)?0:sl_next+SLOTB;}while(0)
  DMA_K(2,2*SLOTB);
  WAIT_BAR(3);
  qkt(pA0,pA1,Kbase,qr,zero16,r32,hi);asm volatile("s_nop 15\n\ts_nop 7":"+v"(pA0),"+v"(pA1));cmask(pA0,pA1,0,qrel,hi);
  START(pA0,pA1);
  _Pragma("unroll") for(int r=0;r<16;++r)pA1[r]=__builtin_amdgcn_exp2f(pA1[r]);
  WAIT_BAR(0);
  DMA_K(3,0);DMA_V(1,SLOTB);
  ROT();
  kload8(kf,kp0+sl_cur);
  WAIT_BAR(2);
  s16x4 vlo[8],vhi[8]; u32x4 pw0,pw1,pw2,pw3;
  #define PKW(P,B) cvtpk_s(P[B],P[B+1])
  #define PAF(k) __builtin_bit_cast(bf16x8,pw##k)
  #define VFR(i) (bf16x8){vlo[i][0],vlo[i][1],vlo[i][2],vlo[i][3],vhi[i][0],vhi[i][1],vhi[i][2],vhi[i][3]}
  #define PIN(x) asm volatile("":"+v"(x))
  #define MX3(a,b,c) __builtin_fmaxf(__builtin_fmaxf((a),(b)),(c))
  #define GAPA(MF,A0,A1,A2,A3,W0,W1,PW) do{ MF; sacc+=A0; sacc+=A1; sacc+=A2; sacc+=A3; PIN(sacc); W0; W1; PIN(PW); SBAR(); }while(0)
  #define EX(v) __builtin_amdgcn_exp2f(v)
  #define GAPB(MF,X,B) do{ MF; X[B]=EX(X[B]); X[B+1]=EX(X[B+1]); X[B+2]=EX(X[B+2]); X[B+3]=EX(X[B+3]); PIN(X); SBAR(); }while(0)
  #define VRD(i) do{ vlo[i]=vtr(vp_+(((i)>>2)*4096+((i)&3)*1024)); vhi[i]=vtr(vp_+(((i)>>2)*4096+((i)&3)*1024+512)); }while(0)
  #define KRD(G,j) do{ if(G){ kload2(kf,kp0+sl_next,j); SBAR(); } }while(0)
  #define STEP(C0,C1,P0,P1,t,GK,GV,GL) do{ SBAR(); \
    const lds_cptr vp_=vp0+sl_prev; \
    VRD(0); SBAR(); float sacc=(P0[0]+P0[1]); \
    GAPA(C0=__builtin_amdgcn_mfma_f32_32x32x16_bf16(kf[0],qr[0],zero16,0,0,0), P0[2],P0[3],P0[4],P0[5],     pw0[0]=PKW(P0,0), pw0[1]=PKW(P0,2), pw0); \
    VRD(4); SBAR(); GAPA(C1=__builtin_amdgcn_mfma_f32_32x32x16_bf16(kf[1],qr[0],zero16,0,0,0), P0[6],P0[7],P0[8],P0[9],     pw0[2]=PKW(P0,4), pw0[3]=PKW(P0,6), pw0); \
    VRD(1); SBAR(); GAPA(C0=__builtin_amdgcn_mfma_f32_32x32x16_bf16(kf[2],qr[1],C0,0,0,0),   P0[10],P0[11],P0[12],P0[13], pw1[0]=PKW(P0,8), pw1[1]=PKW(P0,10), pw1); \
    VRD(5); SBAR(); GAPA(C1=__builtin_amdgcn_mfma_f32_32x32x16_bf16(kf[3],qr[1],C1,0,0,0),   P0[14],P0[15],P1[0],P1[1],   pw1[2]=PKW(P0,12),pw1[3]=PKW(P0,14), pw1); \
    VRD(2); SBAR(); GAPA(C0=__builtin_amdgcn_mfma_f32_32x32x16_bf16(kf[4],qr[2],C0,0,0,0),   P1[2],P1[3],P1[4],P1[5],     pw2[0]=PKW(P1,0), pw2[1]=PKW(P1,2), pw2); \
    VRD(6); SBAR(); GAPA(C1=__builtin_amdgcn_mfma_f32_32x32x16_bf16(kf[5],qr[2],C1,0,0,0),   P1[6],P1[7],P1[8],P1[9],     pw2[2]=PKW(P1,4), pw2[3]=PKW(P1,6), pw2); \
    VRD(3); SBAR(); GAPA(C0=__builtin_amdgcn_mfma_f32_32x32x16_bf16(kf[6],qr[3],C0,0,0,0),   P1[10],P1[11],P1[12],P1[13], pw3[0]=PKW(P1,8), pw3[1]=PKW(P1,10), pw3); \
    VRD(7); SBAR(); GAPA(C1=__builtin_amdgcn_mfma_f32_32x32x16_bf16(kf[7],qr[3],C1,0,0,0),   P1[14],P1[15],0.f,0.f,       pw3[2]=PKW(P1,12),pw3[3]=PKW(P1,14), pw3); \
    l_reg+=sacc; \
    if(GK){DMA_K((t)+3,sl_cur);} if(GV){DMA_V((t)+1,sl_next);} \
    CMASK(C0,C1,t); \
    { float a=MX3(C0[0],C0[1],C1[0]),b=MX3(C0[2],C0[3],C1[1]); a=MX3(a,C1[2],C1[3]); \
      _Pragma("unroll") for(int r=4;r<16;r+=4){a=MX3(a,C0[r],C0[r+1]);b=MX3(b,C0[r+2],C0[r+3]);a=MX3(a,C1[r],C1[r+1]);b=MX3(b,C1[r+2],C1[r+3]);} \
      float rm=__builtin_fmaxf(a,b); { auto rr=__builtin_amdgcn_permlane32_swap(__float_as_uint(rm),__float_as_uint(rm),false,false); rm=__builtin_fmaxf(__uint_as_float(rr[0]),__uint_as_float(rr[1])); } \
      resc=false; \
      if(__builtin_expect(__any(rm>(float)THRL),0)){ const float dl=__builtin_fmaxf(rm,0.f); mhat+=dl; \
        _Pragma("unroll") for(int r=0;r<16;++r){C0[r]-=dl;C1[r]-=dl;} \
        const float f=__builtin_amdgcn_exp2f(-dl); l_reg*=f; if(hi==0)wsf[r32]=f; resc=true; } } \
    SBAR(); \
    GAPB(o[0]=__builtin_amdgcn_mfma_f32_32x32x16_bf16(PAF(0),VFR(0),o[0],0,0,0), C0,0); \
    GAPB(o[1]=__builtin_amdgcn_mfma_f32_32x32x16_bf16(PAF(0),VFR(4),o[1],0,0,0), C0,4); \
    KRD(GL,0); GAPB(o[0]=__builtin_amdgcn_mfma_f32_32x32x16_bf16(PAF(1),VFR(1),o[0],0,0,0), C0,8); \
    KRD(GL,1); GAPB(o[1]=__builtin_amdgcn_mfma_f32_32x32x16_bf16(PAF(1),VFR(5),o[1],0,0,0), C0,12); \
    KRD(GL,2); GAPB(o[0]=__builtin_amdgcn_mfma_f32_32x32x16_bf16(PAF(2),VFR(2),o[0],0,0,0), C1,0); \
    KRD(GL,3); GAPB(o[1]=__builtin_amdgcn_mfma_f32_32x32x16_bf16(PAF(2),VFR(6),o[1],0,0,0), C1,4); \
    GAPB(o[0]=__builtin_amdgcn_mfma_f32_32x32x16_bf16(PAF(3),VFR(3),o[0],0,0,0), C1,8); \
    GAPB(o[1]=__builtin_amdgcn_mfma_f32_32x32x16_bf16(PAF(3),VFR(7),o[1],0,0,0), C1,12); \
    }while(0)
  int t=1;
  #define ENDW(tt) do{ if((tt)+3<NT){WAIT_BAR(2);} else if((tt)+2<NT){WAIT_BAR(1);} else {WAIT_BAR(0);} }while(0)
  for(;t<5&&t+1<NT;t+=2){
    STEP(pB0,pB1,pA0,pA1,t,(t+3<NT),(t+1<NT),(t+1<NT));       ENDW(t);   RESC(); ROT();
    STEP(pA0,pA1,pB0,pB1,t+1,(t+4<NT),(t+2<NT),(t+2<NT));     ENDW(t+1); RESC(); ROT();
  }
  #undef CMASK
  #define CMASK(P0,P1,t) CMASK_ROW(P0,P1,t)
  for(;t+5<NT;t+=2){
    STEP(pB0,pB1,pA0,pA1,t,true,true,true);     WAIT_BAR(2); RESC(); ROT();
    STEP(pA0,pA1,pB0,pB1,t+1,true,true,true);   WAIT_BAR(2); RESC(); ROT();
  }
  for(;t+1<NT;t+=2){
    STEP(pB0,pB1,pA0,pA1,t,(t+3<NT),(t+1<NT),(t+1<NT));       ENDW(t);   RESC(); ROT();
    STEP(pA0,pA1,pB0,pB1,t+1,(t+4<NT),(t+2<NT),(t+2<NT));     ENDW(t+1); RESC(); ROT();
  }
  #undef CMASK
  #define CMASK(P0,P1,t) CMASK_FULL(P0,P1,t)
  STEP(pB0,pB1,pA0,pA1,NT-1,false,false,false); RESC();
  { float sacc=pB0[0]+pB0[1]; _Pragma("unroll") for(int r=2;r<16;++r)sacc+=pB0[r]; _Pragma("unroll") for(int r=0;r<16;++r)sacc+=pB1[r]; l_reg+=sacc;
    pw0=(u32x4){PKW(pB0,0),PKW(pB0,2),PKW(pB0,4),PKW(pB0,6)};pw1=(u32x4){PKW(pB0,8),PKW(pB0,10),PKW(pB0,12),PKW(pB0,14)};pw2=(u32x4){PKW(pB1,0),PKW(pB1,2),PKW(pB1,4),PKW(pB1,6)};pw3=(u32x4){PKW(pB1,8),PKW(pB1,10),PKW(pB1,12),PKW(pB1,14)};
    SBAR(); pv(o,vb0+sl_cur,PAF(0),PAF(1),PAF(2),PAF(3)); }
  #undef PKW
  #undef PAF
  #undef VFR
  #undef PIN
  #undef MX3
  #undef GAPA
  #undef GAPB
  #undef EX
  #undef VRD
  #undef KRD
  #undef STEP
  #undef ENDW
  {auto rr=__builtin_amdgcn_permlane32_swap(__float_as_uint(l_reg),__float_as_uint(l_reg),false,false);l_reg=__uint_as_float(rr[0])+__uint_as_float(rr[1]);}
  if(hi==0)wsf[32+r32]=l_reg;asm volatile("s_waitcnt lgkmcnt(0)":::"memory");
  float rli[16];
  #pragma unroll
  for(int r=0;r<16;++r)rli[r]=__builtin_amdgcn_rcpf(wsf[32+crow(r,hi)]);
  bf16*Ow=O+(rowbase+q0+wid*QBLK)*DM+h*D;
  { bf16*stg=(bf16*)(shm+LDS_OST)+wid*2048;
    #pragma unroll
    for(int r=0;r<16;++r){const int orow=crow(r,hi);
      #pragma unroll
      for(int d0=0;d0<2;++d0)stg[orow*64+d0*32+r32]=__float2bfloat16(o[d0][r]*rli[r]);}
    asm volatile("s_waitcnt lgkmcnt(0)":::"memory");
    #pragma unroll
    for(int i=0;i<4;++i){const int row=i*8+(lane>>3),ch=lane&7; const u32x4 v=*(const u32x4*)(stg+row*64+ch*8); ATTN_STORE16(Ow+(long)row*DM+ch*8,v);} }
  asm volatile("s_waitcnt lgkmcnt(0)\n\ts_barrier":::"memory");
  #undef DMA_K
  #undef TILE
  #undef DMA_V
  #undef CMASK
  #undef CMASK_ROW
  #undef CMASK_FULL
  #undef START
  #undef RESC
  #undef ROT
}
constexpr int ATTN_LDS_BYTES=LDS_BYTES;
struct AttnTensors { const bf16* Q; const bf16* K; const bf16* V; bf16* O; const float* KM; };
struct AttnUnit { int bh; int qb; };
struct StaticOrder {
  int vcu,G;
  __device__ __forceinline__ explicit StaticOrder(int grid,int block):vcu((grid%8==0)?(block%8)*(grid/8)+block/8:block),G(grid){}
  __device__ __forceinline__ bool next(int i,AttnUnit&u)const{ const int pr=(i>>1)*G+vcu; if(pr>=256)return false; const int s=pr&15; u.bh=pr>>4; u.qb=(i&1)?31-s:s; return true; }
};
template<class Sched,int THRL=8> __device__ __forceinline__ void attn_phase(char*lds,const AttnTensors&T,const Sched&S){
  AttnUnit u;
  int last_bh=-1;
  for(int i=0;S.next(i,u);++i){ attn_unit<THRL>(u.bh/NHEAD,u.bh%NHEAD,u.qb,T.Q,T.K,T.V,T.O,T.KM,lds,u.bh!=last_bh); last_bh=u.bh; }
}
#undef SBAR
#undef WAIT_BAR
}
namespace xb {
#define GAS __attribute__((address_space(1)))
#define LAS __attribute__((address_space(3)))
typedef GAS unsigned gu32;
typedef GAS unsigned long long gu64;
#define RLX_AGENT __ATOMIC_RELAXED, __HIP_MEMORY_SCOPE_AGENT
#define LDS_WAIT() asm volatile("s_waitcnt lgkmcnt(0)" ::: "memory")
#define VM_WAIT() asm volatile("s_waitcnt vmcnt(0)" ::: "memory")
__device__ __forceinline__ unsigned long long rt() { return __builtin_amdgcn_s_memrealtime(); }
#define XB_TMO      128
#define XB_XCNT(j)  (256  + 64 * (j))
#define XB_XSUB(j)  (1280 + 64 * (j))
#define XB_XGEN(j)  (2304 + 64 * (j))
#define XB_TOP      3328
#define XB_TOPGEN   3392
#define XCD_BAR_WORDS 3456
#define XB_SPIN_CAP (1u << 18)

__device__ __forceinline__ unsigned xb_ld(unsigned* p)              { return __hip_atomic_load(p, __ATOMIC_RELAXED, __HIP_MEMORY_SCOPE_AGENT); }
__device__ __forceinline__ unsigned xb_add(unsigned* p, unsigned v) { return __hip_atomic_fetch_add(p, v, __ATOMIC_RELAXED, __HIP_MEMORY_SCOPE_AGENT); }
__device__ __forceinline__ unsigned xb_xcc_id() { return (unsigned)__builtin_amdgcn_s_getreg((3 << 11) | 20) & 0xFu; }
#define XB_SPIN(cond, bar) do { unsigned _sp = 0; while (cond) { __builtin_amdgcn_s_sleep(1); \
    if ((++_sp & 255u) == 0u) { if (xb_ld(&(bar)[XB_TMO])) break; if (_sp > XB_SPIN_CAP) { atomicAdd(&(bar)[XB_TMO], 1u); break; } } } } while (0)

struct XcdBarrier {
    unsigned* bar; unsigned x;
    volatile LAS unsigned* st;
};

__device__ __forceinline__ XcdBarrier xcd_barrier_post(unsigned* bar, volatile LAS unsigned* st) {
    XcdBarrier b; b.bar = bar; b.x = xb_xcc_id(); b.st = st;
    if (threadIdx.x == 0) (void)xb_add(&bar[XB_XCNT(b.x)], 1u);
    return b;
}
__device__ __forceinline__ void xcd_barrier_complete(unsigned* bar, unsigned x, unsigned& nloc, unsigned& nx) {
    const unsigned G = gridDim.x * gridDim.y * gridDim.z;
    unsigned sum, cnt, mine, sp = 0u;
    for (;;) {
        sum = 0u; cnt = 0u; mine = 0u;
#pragma unroll
        for (unsigned j = 0; j < 16; ++j) { const unsigned c = xb_ld(&bar[XB_XCNT(j)]); sum += c; cnt += (c > 0u) ? 1u : 0u; mine = (j == x) ? c : mine; }
        if (sum == G) break;
        __builtin_amdgcn_s_sleep(1);
        if ((++sp & 255u) == 0u) { if (xb_ld(&bar[XB_TMO])) break; if (sp > XB_SPIN_CAP) { atomicAdd(&bar[XB_TMO], 1u); break; } }
    }
    nloc = mine > 0u ? mine : 1u; nx = cnt > 0u ? cnt : 1u;
}

__device__ __forceinline__ void xcd_barrier(const XcdBarrier& b) {
    asm volatile("s_waitcnt vmcnt(0)" ::: "memory");
    __syncthreads();
    if (threadIdx.x == 0) {
        unsigned* bar = b.bar;
        __builtin_amdgcn_s_waitcnt(0);
        unsigned nloc = b.st[0], nx = b.st[1];
        if (nloc == 0u) { xcd_barrier_complete(bar, b.x, nloc, nx); b.st[0] = nloc; b.st[1] = nx; }
        const unsigned old = xb_add(&bar[XB_XSUB(b.x)], 1u);
        const unsigned gen = old / nloc;
        if (old + 1u == (gen + 1u) * nloc) {
            __builtin_amdgcn_fence(__ATOMIC_RELEASE, "agent");
            asm volatile("s_waitcnt vmcnt(0)" ::: "memory");
            const unsigned og = xb_add(&bar[XB_TOP], 1u);
            const unsigned tg = og / nx;
            if (og + 1u == (tg + 1u) * nx) xb_add(&bar[XB_TOPGEN], 1u);
            else XB_SPIN(xb_ld(&bar[XB_TOPGEN]) == tg, bar);
            __builtin_amdgcn_fence(__ATOMIC_ACQUIRE, "agent");
            xb_add(&bar[XB_XGEN(b.x)], 1u);
            asm volatile("s_waitcnt vmcnt(0)" ::: "memory");
        } else {
            XB_SPIN(xb_ld(&bar[XB_XGEN(b.x)]) == gen, bar);
            __builtin_amdgcn_fence(__ATOMIC_ACQUIRE, "agent");
            asm volatile("s_waitcnt vmcnt(0)" ::: "memory");
        }
    }
    __syncthreads();
}

#define XB_LSUB(j)  (3456 + 64 * (j))
#define XB_LGEN(j)  (4480 + 64 * (j))
#define XB_CLS(j)   (5504 + 64 * (j))
#define XB_MISMATCH 6528
__device__ __forceinline__ void xcd_local_post(const XcdBarrier& b) {
    if (threadIdx.x == 0) { const unsigned cls = 1u + (blockIdx.x & 7u); unsigned expect = 0u;
        if (!__hip_atomic_compare_exchange_strong(&b.bar[XB_CLS(b.x)], &expect, cls, __ATOMIC_RELAXED, __ATOMIC_RELAXED, __HIP_MEMORY_SCOPE_AGENT) && expect != cls) xb_add(&b.bar[XB_MISMATCH], 1u); }
}
__device__ __forceinline__ bool xcd_local_ok(const XcdBarrier& b) {
    const unsigned nloc = b.st[0], nx = b.st[1];
    return xb_ld(&b.bar[XB_MISMATCH]) == 0u && nx == 8u && nloc * 8u == gridDim.x;
}
__device__ __forceinline__ void xcd_barrier_local(const XcdBarrier& b) {
    asm volatile("s_waitcnt vmcnt(0)" ::: "memory");
    __syncthreads();
    if (threadIdx.x == 0) {
        unsigned* bar = b.bar; const unsigned nloc = b.st[0];
        const unsigned old = xb_add(&bar[XB_LSUB(b.x)], 1u), gen = old / nloc;
        if (old + 1u == (gen + 1u) * nloc) xb_add(&bar[XB_LGEN(b.x)], 1u);
        else XB_SPIN(xb_ld(&bar[XB_LGEN(b.x)]) == gen, bar);
        __builtin_amdgcn_fence(__ATOMIC_ACQUIRE, "agent");
        asm volatile("s_waitcnt vmcnt(0)" ::: "memory");
    }
    __syncthreads();
}
}
#ifndef REP_CONV
#define REP_CONV 1
#endif
#ifndef REP_SGU
#define REP_SGU 1
#endif
namespace mk {
typedef unsigned short bf16;
typedef float f32x4 __attribute__((ext_vector_type(4)));
typedef float f32x2 __attribute__((ext_vector_type(2)));
typedef unsigned u32x4 __attribute__((ext_vector_type(4)));
typedef unsigned u32x2 __attribute__((ext_vector_type(2)));
typedef short bf16x8 __attribute__((ext_vector_type(8)));
typedef __bf16 bf16x2_t __attribute__((ext_vector_type(2)));

constexpr int NWV = 8, NTHR = 512;
constexpr int SEQ = 8192, TOK = 2 * SEQ, DM = 1024, FF = 2816, NIN = 6656, CW = 512, NLAYER = 2;
constexpr float EPS = 1e-6f;
constexpr float C2 = 0.125f * 1.4426950408889634f;
constexpr size_t MiB = 1u << 20;
constexpr size_t WS_ROPE = 1 * MiB, WS_KMEAN = 2 * MiB, WS_SS = MiB + MiB / 2;
constexpr size_t WS_WFI = 4 * MiB, WS_WFO = 15 * MiB, WS_WIN = 21 * MiB, WS_WBR = 34 * MiB, WS_WOUT = 37 * MiB;
constexpr size_t WS_XN = 40 * MiB;
constexpr size_t WS_K = 72 * MiB, WS_V = 88 * MiB, WS_MERGED = 72 * MiB;
constexpr size_t WS_ACT = 104 * MiB;
constexpr size_t ARENA = 11 * MiB, WS_GLU = WS_ACT, WS_U = WS_ACT + 2 * MiB;
__host__ __device__ __forceinline__ size_t arena_off(int row) { return (size_t)(row >> 11) * (ARENA / 2) + (size_t)(row & 2047) * 512; }
constexpr size_t WS_GATES = 192 * MiB;
constexpr size_t WS_FALT_WI = 240 * MiB, WS_FALT_WO = 251 * MiB, WS_END = 256 * MiB + MiB / 2;
constexpr int LDS_RS = 131072 + 256, LDS_GB = LDS_RS + 8 * 256 * 4, LDS_BYTES = LDS_GB + 8 * 256 * 4;

__device__ __forceinline__ float bf2f(unsigned h) { return __uint_as_float(h << 16); }
__device__ __forceinline__ float bflo(unsigned u) { return __uint_as_float(u << 16); }
__device__ __forceinline__ float bfhi(unsigned u) { return __uint_as_float(u & 0xffff0000u); }
__device__ __forceinline__ unsigned pk2(float lo, float hi) { f32x2 v = {lo, hi}; bf16x2_t b = __builtin_convertvector(v, bf16x2_t); return __builtin_bit_cast(unsigned, b); }
__device__ __forceinline__ float sigm(float a) { return __builtin_amdgcn_rcpf(1.f + __builtin_amdgcn_exp2f(-1.4426950408889634f * a)); }
__device__ __forceinline__ f32x4 exp2v(f32x4 t) { return (f32x4){__builtin_amdgcn_exp2f(t[0]), __builtin_amdgcn_exp2f(t[1]), __builtin_amdgcn_exp2f(t[2]), __builtin_amdgcn_exp2f(t[3])}; }
__device__ __forceinline__ f32x4 rcpv(f32x4 t) { return (f32x4){__builtin_amdgcn_rcpf(t[0]), __builtin_amdgcn_rcpf(t[1]), __builtin_amdgcn_rcpf(t[2]), __builtin_amdgcn_rcpf(t[3])}; }
__device__ __forceinline__ f32x4 sigmv_neg(f32x4 tneg) { return rcpv(exp2v(tneg) + 1.0f); }
__device__ __forceinline__ float gelu_tanh(float x) { return x * sigm(1.5957691216057308f * (x + 0.044715f * x * x * x)); }
#define MK_DPP_ADD(v, ctrl) ((v) + __builtin_bit_cast(float, __builtin_amdgcn_update_dpp(0, __builtin_bit_cast(int, (v)), (ctrl), 0xF, 0xF, true)))
__device__ __forceinline__ float wave_sum(float v) {
    v = MK_DPP_ADD(v, 0xB1);
    v = MK_DPP_ADD(v, 0x4E);
    v = MK_DPP_ADD(v, 0x141);
    v = MK_DPP_ADD(v, 0x140);
    { auto r = __builtin_amdgcn_permlane16_swap(__float_as_uint(v), __float_as_uint(v), false, false); v = __uint_as_float(r[0]) + __uint_as_float(r[1]); }
    { auto r = __builtin_amdgcn_permlane32_swap(__float_as_uint(v), __float_as_uint(v), false, false); v = __uint_as_float(r[0]) + __uint_as_float(r[1]); }
    return v;
}
__device__ __forceinline__ void store8(bf16* p, f32x4 a, f32x4 b) { u32x4 w; w.x = pk2(a[0], a[1]); w.y = pk2(a[2], a[3]); w.z = pk2(b[0], b[1]); w.w = pk2(b[2], b[3]); *(u32x4*)p = w; }
__device__ __forceinline__ unsigned q8(float v) { return (unsigned)(v * 255.f + 0.5f); }
__device__ __forceinline__ void store8_u8(unsigned char* p, f32x4 a, f32x4 b) { u32x2 w; w.x = q8(a[0]) | (q8(a[1]) << 8) | (q8(a[2]) << 16) | (q8(a[3]) << 24); w.y = q8(b[0]) | (q8(b[1]) << 8) | (q8(b[2]) << 16) | (q8(b[3]) << 24); *(u32x2*)p = w; }
__device__ __forceinline__ void unpack8_u8(u32x2 w, f32x4& a, f32x4& b) { const float k = 1.f / 255.f;
    a = (f32x4){(float)(w.x & 255u) * k, (float)((w.x >> 8) & 255u) * k, (float)((w.x >> 16) & 255u) * k, (float)(w.x >> 24) * k};
    b = (f32x4){(float)(w.y & 255u) * k, (float)((w.y >> 8) & 255u) * k, (float)((w.y >> 16) & 255u) * k, (float)(w.y >> 24) * k}; }
__device__ __forceinline__ void unpack8(u32x4 w, f32x4& a, f32x4& b) { a = (f32x4){bflo(w.x), bfhi(w.x), bflo(w.y), bfhi(w.y)}; b = (f32x4){bflo(w.z), bfhi(w.z), bflo(w.w), bfhi(w.w)}; }

__device__ __forceinline__ float row_rs(const float* ss, int row) { const f32x4 p = *(const f32x4*)(ss + (size_t)row * 4); return 1.0f / sqrtf(((p.x + p.y) + (p.z + p.w)) * (1.f / DM) + EPS); }
struct EpiSwiGLU {
#ifdef DUP_EPI
    static constexpr bool DUP = true;
#endif
    static constexpr bool PERM = true, AFTER_DRAIN = false, KEEP_ACC = false;
    unsigned char* ws; const PG8_LAS float* rsl; mutable int ui;
    __device__ __forceinline__ void operator()(const f32x4 (&acc)[2][2][4][2], const pg8::Unit& u, int wr, int wc, int fr, int fq) const {
        bf16* O = (bf16*)(ws + WS_ACT); constexpr int ldc = FF; const PG8_LAS float* rl = rsl + ui * 256 + wr * 64 + fr; ++ui;
        const int row0 = u.pm * 256 + wr * 64 + fr, col = u.pn * 128 + wc * 32 + 8 * fq;
        float rsv[2][4];
#pragma unroll
        for (int ai = 0; ai < 2; ++ai)
#pragma unroll
            for (int m = 0; m < 4; ++m) rsv[ai][m] = rl[ai * 128 + m * 16];
#pragma unroll
        for (int ai = 0; ai < 2; ++ai)
#pragma unroll
            for (int m = 0; m < 4; ++m) {
                const int row = row0 + ai * 128 + m * 16; const float rs = rsv[ai][m];
                const float kneg = -1.4426950408889634f * rs, rs2 = rs * rs;
                const f32x4 o0 = (acc[ai][0][m][0] * acc[ai][1][m][0]) * (sigmv_neg(acc[ai][0][m][0] * kneg) * rs2);
                const f32x4 o1 = (acc[ai][0][m][1] * acc[ai][1][m][1]) * (sigmv_neg(acc[ai][0][m][1] * kneg) * rs2);
                store8(O + (size_t)row * ldc + col, o0, o1);
            }
    }
};
struct EpiResid {
    static constexpr bool PERM = true, AFTER_DRAIN = true, KEEP_ACC = false;
    float scale; unsigned char* ws;
    __device__ __forceinline__ void fused(f32x4 (&acc)[2][2][4][2], const pg8::Unit& u, int wr, int wc, int fr, int fq, PG8_LAS unsigned char* lds, int wid, int lane) const {
        bf16* XB = (bf16*)(ws + WS_XN); float* SS = (float*)(ws + WS_SS);
        const int col0 = u.pn * 256 + wc * 32 + 8 * fq;
        PG8_LAS float* Pl = (PG8_LAS float*)lds;
        u32x4 bv[2][4][2];
#pragma unroll
        for (int ai = 0; ai < 2; ++ai)
#pragma unroll
            for (int m = 0; m < 4; ++m)
#pragma unroll
                for (int bj = 0; bj < 2; ++bj) bv[ai][m][bj] = *(const u32x4*)(XB + (size_t)(u.pm * 256 + ai * 128 + wr * 64 + m * 16 + fr) * DM + col0 + bj * 128);
#pragma unroll
        for (int ai = 0; ai < 2; ++ai)
#pragma unroll
            for (int m = 0; m < 4; ++m) {
                const int rl = ai * 128 + wr * 64 + m * 16 + fr; float s = 0.f;
#pragma unroll
                for (int bj = 0; bj < 2; ++bj) {
                    const size_t off = (size_t)(u.pm * 256 + rl) * DM + col0 + bj * 128;
                    f32x4 b0, b1; unpack8(bv[ai][m][bj], b0, b1);
                    const f32x4 x0 = b0 + acc[ai][bj][m][0] * scale, x1 = b1 + acc[ai][bj][m][1] * scale;
                    store8(XB + off, x0, x1);
                    s += (x0.x * x0.x + x0.y * x0.y) + (x0.z * x0.z + x0.w * x0.w) + (x1.x * x1.x + x1.y * x1.y) + (x1.z * x1.z + x1.w * x1.w);
                }
                { auto r = __builtin_amdgcn_permlane16_swap(__float_as_uint(s), __float_as_uint(s), false, false); s = __uint_as_float(r[0]) + __uint_as_float(r[1]); }
                { auto r = __builtin_amdgcn_permlane32_swap(__float_as_uint(s), __float_as_uint(s), false, false); s = __uint_as_float(r[0]) + __uint_as_float(r[1]); }
                if (fq == 0) Pl[rl * 4 + wc] = s;
            }
        asm volatile("s_waitcnt lgkmcnt(0)" ::: "memory"); __builtin_amdgcn_s_barrier(); asm volatile("" ::: "memory");
        const int tid = wid * 64 + lane;
        if (tid < 256) { const PG8_LAS f32x4* P4 = (const PG8_LAS f32x4*)lds; const f32x4 p = P4[tid]; SS[(size_t)(u.pm * 256 + tid) * 4 + u.pn] = (p.x + p.y) + (p.z + p.w); }
    }
};
struct EpiWin {
#ifdef DUP_EPI
    static constexpr bool DUP = false;
#endif
    static constexpr bool PERM = true, AFTER_DRAIN = false, KEEP_ACC = false;
    unsigned char* ws; const float* gate_b; const PG8_LAS float* rsl; mutable int ui; unsigned char* ob;
    __device__ __forceinline__ void operator()(const f32x4 (&acc)[2][2][4][2], const pg8::Unit& u, int wr, int wc, int fr, int fq) const {
        const PG8_LAS float* rl = rsl + ui * 256 + wr * 64 + fr; ++ui;
        const size_t cls_ = (size_t)(u.pm >> 3) * (ARENA / 2) - (size_t)(u.pm >> 3) * 2048 * CW;
        bf16 *GLU = (bf16*)(ws + WS_GLU) + cls_, *U = (bf16*)(ws + WS_U) + cls_, *SV = (bf16*)(ob + 48 * MiB), *Q = (bf16*)(ob + 32 * MiB), *K = (bf16*)(ws + WS_K), *V = (bf16*)(ws + WS_V), *GATES_unused = nullptr; unsigned char* GATES = ws + WS_GATES; (void)GATES_unused;
        const float* rope = (const float*)(ws + WS_ROPE);
        const int pn = u.pn, row0 = u.pm * 256 + wr * 64 + fr, cw = wc * 32 + 8 * fq;
        float rsv[2][4];
#pragma unroll
        for (int ai = 0; ai < 2; ++ai)
#pragma unroll
            for (int m = 0; m < 4; ++m) rsv[ai][m] = rl[ai * 128 + m * 16];
        if (pn < 4) {
#pragma unroll
            for (int ai = 0; ai < 2; ++ai)
#pragma unroll
                for (int m = 0; m < 4; ++m) {
                    const float rs = rsv[ai][m], kneg = -1.4426950408889634f * rs;
                    const f32x4 o0 = acc[ai][0][m][0] * (sigmv_neg(acc[ai][1][m][0] * kneg) * rs), o1 = acc[ai][0][m][1] * (sigmv_neg(acc[ai][1][m][1] * kneg) * rs);
                    store8(GLU + (size_t)(row0 + ai * 128 + m * 16) * CW + pn * 128 + cw, o0, o1);
                }
        } else if (pn < 8) {
            bf16* dst = (pn < 6) ? U : SV; const int cb = (pn & 1) * 256 + cw;
#pragma unroll
            for (int ai = 0; ai < 2; ++ai)
#pragma unroll
                for (int m = 0; m < 4; ++m) { const float rs = rsv[ai][m];
#pragma unroll
                    for (int bj = 0; bj < 2; ++bj) {
                        const f32x4 x0 = acc[ai][bj][m][0] * rs, x1 = acc[ai][bj][m][1] * rs;
                        const f32x4 o0 = x0 * sigmv_neg((x0 * (x0 * x0 * 0.044715f + 1.0f)) * -2.3022082f), o1 = x1 * sigmv_neg((x1 * (x1 * x1 * 0.044715f + 1.0f)) * -2.3022082f);
                        store8(dst + (size_t)(row0 + ai * 128 + m * 16) * CW + cb + bj * 128, o0, o1);
                    } }
        } else if (pn < 12) {
            bf16* dst = (pn < 10) ? Q : K; const float sc = (pn < 10) ? C2 : 1.f; const int cb = (pn & 1) * 256 + cw;
            const bool ropew = (wc & 1) == 0;
#pragma unroll
            for (int bj = 0; bj < 2; ++bj) {
#pragma unroll
                for (int ai = 0; ai < 2; ++ai)
#pragma unroll
                    for (int m = 0; m < 4; ++m) {
                        const int row = row0 + ai * 128 + m * 16, pos = row & (SEQ - 1);
                        f32x4 v0 = acc[ai][bj][m][0], v1 = acc[ai][bj][m][1];
                        if (ropew) {
                            f32x4 c0 = {1.f, 1.f, 1.f, 1.f}, c1 = c0, s0 = {0.f, 0.f, 0.f, 0.f}, s1 = s0;
                            if (fq < 2) {
                                const float fp = (float)pos;
                                const float invf[8] = {1.0f, 0.1939227432012558f, 0.03760603070259094f, 0.007292664609849453f, 0.0014142135623842478f, 0.00027424818836152554f, 5.318296098266728e-05f, 1.0313386155758053e-05f};
#pragma unroll
                                for (int e = 0; e < 8; ++e) { const float a = fp * invf[e], p = a * 0.15915493667125702f, lo = __builtin_fmaf(a, 0.15915493667125702f, -p) + a * 6.4206382e-09f;
                                    const float r = __builtin_amdgcn_fractf(p) + lo; const float cv = __builtin_amdgcn_cosf(r), sv = __builtin_amdgcn_sinf(r);
                                    if (e < 4) { c0[e] = cv; s0[e] = sv; } else { c1[e - 4] = cv; s1[e - 4] = sv; } }
                            }
                            if (fq == 0) { s0 = -s0; s1 = -s1; }
                            f32x4 p0, p1;
#pragma unroll
                            for (int e = 0; e < 4; ++e) { p0[e] = __shfl_xor(v0[e], 16); p1[e] = __shfl_xor(v1[e], 16); }
                            v0 = v0 * c0 + p0 * s0; v1 = v1 * c1 + p1 * s1;
                        }
                        { const float scr = sc * rsv[ai][m]; store8(dst + (size_t)row * CW + cb + bj * 128, v0 * scr, v1 * scr); }
                    }
            }
        } else if (pn < 14) {
            const int cb = (pn & 1) * 256 + cw;
#pragma unroll
            for (int ai = 0; ai < 2; ++ai)
#pragma unroll
                for (int m = 0; m < 4; ++m)
#pragma unroll
                    for (int bj = 0; bj < 2; ++bj) { const float rs = rsv[ai][m]; store8(V + (size_t)(row0 + ai * 128 + m * 16) * CW + cb + bj * 128, acc[ai][bj][m][0] * rs, acc[ai][bj][m][1] * rs); }
        } else {
            const int gc = (pn - 14) * 256 + cw;
#pragma unroll
            for (int bj = 0; bj < 2; ++bj) {
                const PG8_LAS float* gbl = rsl + (LDS_GB - LDS_RS) / 4 + (ui - 1) * 256 + cw + bj * 128;
                const f32x4 bn0 = *(const PG8_LAS f32x4*)gbl * -1.4426950408889634f, bn1 = *(const PG8_LAS f32x4*)(gbl + 4) * -1.4426950408889634f;
#pragma unroll
                for (int ai = 0; ai < 2; ++ai)
#pragma unroll
                    for (int m = 0; m < 4; ++m) {
                        const float kneg = -1.4426950408889634f * rsv[ai][m];
                        const f32x4 o0 = sigmv_neg(acc[ai][bj][m][0] * kneg + bn0), o1 = sigmv_neg(acc[ai][bj][m][1] * kneg + bn1);
                        store8_u8(GATES + (size_t)(row0 + ai * 128 + m * 16) * 3072 + gc + bj * 128, o0, o1);
                    }
            }
        }
    }
};
struct EpiBranch {
#ifdef DUP_EPI
    static constexpr bool DUP = false;
#endif
    static constexpr bool PERM = true, AFTER_DRAIN = false, KEEP_ACC = true;
    const unsigned char* GATES; bf16* MERGED;
    __device__ __forceinline__ bool keep(const pg8::Unit& u) const { return (u.pm >> 6) < 2; }
    __device__ __forceinline__ void inplace(f32x4 (&acc)[2][2][4][2], const pg8::Unit& u, int wr, int wc, int fr, int fq) const {
        const int br = u.pm >> 6, row0 = (u.pm & 63) * 256 + wr * 64 + fr, col0 = (u.pn & 3) * 256 + wc * 32 + 8 * fq;
        u32x2 ga[2][4][2], gb[2][4][2];
#pragma unroll
        for (int ai = 0; ai < 2; ++ai)
#pragma unroll
            for (int m = 0; m < 4; ++m)
#pragma unroll
                for (int bj = 0; bj < 2; ++bj) {
                    const unsigned char* gp = GATES + (size_t)(row0 + ai * 128 + m * 16) * 3072 + br * 1024 + col0 + bj * 128;
                    ga[ai][m][bj] = *(const u32x2*)gp; gb[ai][m][bj] = (br < 2) ? *(const u32x2*)(gp + 1024) : (u32x2){0u, 0u};
                }
#pragma unroll
        for (int ai = 0; ai < 2; ++ai)
#pragma unroll
            for (int m = 0; m < 4; ++m)
#pragma unroll
                for (int bj = 0; bj < 2; ++bj) {
                    const int row = row0 + ai * 128 + m * 16, col = col0 + bj * 128;
                    f32x4 g0, g1; unpack8_u8(ga[ai][m][bj], g0, g1);
                    if (br > 0) {
#pragma unroll
                        for (int e = 0; e < 4; ++e) { g0[e] = __builtin_fmaxf(g0[e], 1e-6f); g1[e] = __builtin_fmaxf(g1[e], 1e-6f); } }
                    if (br < 2) {
                        f32x4 h0, h1; unpack8_u8(gb[ai][m][bj], h0, h1);
#pragma unroll
                        for (int e = 0; e < 4; ++e) { acc[ai][bj][m][0][e] *= g0[e] * __builtin_amdgcn_rcpf(__builtin_fmaxf(h0[e], 1e-6f)); acc[ai][bj][m][1][e] *= g1[e] * __builtin_amdgcn_rcpf(__builtin_fmaxf(h1[e], 1e-6f)); }
                    } else {
                        store8(MERGED + (size_t)row * DM + col, g0 * acc[ai][bj][m][0], g1 * acc[ai][bj][m][1]);
                    }
                }
    }
};
struct BranchOrder {
    pg8::StaticOrder base;
    __device__ __forceinline__ bool next(int r, pg8::Unit& u) const { pg8::Unit t; if (!base.next(r / 3, t)) return false; const int i = r % 3; u.pm = i * 64 + t.pm; u.pn = i * 4 + t.pn; return true; }
    __device__ __forceinline__ void a_ready(const pg8::Unit&) const {}
    __device__ __forceinline__ void done(const pg8::Unit&) const {}
};

struct Frame { unsigned char* lds; int tid, lane, wave, G, gw, ngw, bx; };
__device__ __forceinline__ void frame_refresh(Frame& F) { int t = threadIdx.x; asm volatile("" : "+v"(t)); int g = gridDim.x, bx = blockIdx.x; asm volatile("" : "+s"(g), "+s"(bx));
    F.tid = t; F.lane = t & 63; F.wave = __builtin_amdgcn_readfirstlane(t >> 6); F.G = g; F.bx = bx; F.gw = bx * NWV + F.wave; F.ngw = g * NWV; }

__device__ __forceinline__ int map_row(int mode, int n) {
    if (mode == 1) { const int up = n >= FF, j = up ? n - FF : n; return 256 * (j >> 7) + (up ? 128 : 0) + (j & 127); }
    if (mode == 2) { if (n >= 1024) return n; const int j = n & 511; return 256 * (j >> 7) + ((n >> 9) ? 128 : 0) + (j & 127); }
    return n;
}
__device__ __forceinline__ void cvt_weight(const Frame& F, const float* __restrict__ W, int K, int N, bf16* WT, int mode, const float* __restrict__ gk, int& base) {
    const int nblk = N / 64, nitems = (K / 64) * nblk, lane = F.lane, q = lane >> 4, c = lane & 15;
    int first = F.gw - (base % F.ngw); if (first < 0) first += F.ngw;
    base += nitems;
    for (int item = first; item < nitems; item += F.ngw) {
        const int kb = item / nblk, nb = item % nblk, k0 = 64 * kb + 16 * q, n0 = 64 * nb;
        const f32x4* src = (const f32x4*)(W + (size_t)k0 * N + n0 + 4 * c);
        f32x4 v[16];
#pragma unroll
        for (int i = 0; i < 16; ++i) v[i] = __builtin_nontemporal_load(src + (size_t)i * (N / 4));
        if (gk) {
            f32x4 g4[4];
#pragma unroll
            for (int i = 0; i < 4; ++i) g4[i] = *(const f32x4*)(gk + k0 + 4 * i);
#pragma unroll
            for (int i = 0; i < 16; ++i) v[i] = v[i] * g4[i >> 2][i & 3];
        }
        bf16* dst = WT + (size_t)(map_row(mode, n0) + 4 * c) * K + k0;
#pragma unroll
        for (int j = 0; j < 4; ++j) {
            u32x4 o0, o1;
            o0.x = pk2(v[0][j], v[1][j]); o0.y = pk2(v[2][j], v[3][j]); o0.z = pk2(v[4][j], v[5][j]); o0.w = pk2(v[6][j], v[7][j]);
            o1.x = pk2(v[8][j], v[9][j]); o1.y = pk2(v[10][j], v[11][j]); o1.z = pk2(v[12][j], v[13][j]); o1.w = pk2(v[14][j], v[15][j]);
            *(u32x4*)(dst + (size_t)j * K) = o0; *(u32x4*)(dst + (size_t)j * K + 8) = o1;
        }
    }
}
__device__ __forceinline__ void norm_rows(const Frame& F, const float* x, const float* __restrict__ g, bf16* xn) {
    f32x4 gv[4];
#pragma unroll
    for (int j = 0; j < 4; ++j) gv[j] = ((const f32x4*)g)[F.lane + 64 * j];
    for (int m = F.gw; m < TOK; m += F.ngw) {
        const f32x4* xr = (const f32x4*)(x + (size_t)m * DM) + F.lane; f32x4 v[4]; float s = 0.f;
#pragma unroll
        for (int j = 0; j < 4; ++j) { v[j] = xr[64 * j]; s += (v[j].x * v[j].x + v[j].y * v[j].y) + (v[j].z * v[j].z + v[j].w * v[j].w); }
        const float rs = 1.0f / sqrtf(wave_sum(s) * (1.f / DM) + EPS);
        u32x2* o = (u32x2*)(xn + (size_t)m * DM) + F.lane;
#pragma unroll
        for (int j = 0; j < 4; ++j) { const f32x4 y = v[j] * rs * gv[j]; u32x2 w; w.x = pk2(y.x, y.y); w.y = pk2(y.z, y.w); o[64 * j] = w; }
    }
}
__device__ __forceinline__ void prep_rows(const Frame& F, const float* x, bf16* xb, float* ss) {
    for (int m0 = F.gw; m0 < TOK; m0 += 2 * F.ngw) {
        f32x4 v[2][4];
#pragma unroll
        for (int r = 0; r < 2; ++r) { const int m = m0 + r * F.ngw; if (m < TOK) { const f32x4* xr = (const f32x4*)(x + (size_t)m * DM) + F.lane;
#pragma unroll
            for (int j = 0; j < 4; ++j) v[r][j] = __builtin_nontemporal_load(xr + 64 * j); } }
#pragma unroll
        for (int r = 0; r < 2; ++r) { const int m = m0 + r * F.ngw; if (m < TOK) { float s = 0.f;
#pragma unroll
            for (int j = 0; j < 4; ++j) s += (v[r][j].x * v[r][j].x + v[r][j].y * v[r][j].y) + (v[r][j].z * v[r][j].z + v[r][j].w * v[r][j].w);
            s = wave_sum(s);
            u32x2* o = (u32x2*)(xb + (size_t)m * DM) + F.lane;
#pragma unroll
            for (int j = 0; j < 4; ++j) { u32x2 w; w.x = pk2(v[r][j].x, v[r][j].y); w.y = pk2(v[r][j].z, v[r][j].w); o[64 * j] = w; }
            if (F.lane == 0) *(f32x4*)(ss + (size_t)m * 4) = (f32x4){s, 0.f, 0.f, 0.f}; } }
    }
}
__device__ __forceinline__ void final_norm_rows(const Frame& F, const bf16* xb, const float* ss, float* out, const float* __restrict__ g) {
    f32x4 gv[2][2];
#pragma unroll
    for (int j = 0; j < 2; ++j) { gv[j][0] = *(const f32x4*)(g + 512 * j + 8 * F.lane); gv[j][1] = *(const f32x4*)(g + 512 * j + 8 * F.lane + 4); }
    const int rbase = (F.bx & 7) * 2048 + (F.bx >> 3) * 8 + F.wave;
#pragma unroll 1
    for (int k0 = 0; k0 < 8; k0 += 4) {
        u32x4 raw[4][2]; float rs[4];
#pragma unroll
        for (int r = 0; r < 4; ++r) { const int m = rbase + 256 * (k0 + r);
#pragma unroll
            for (int j = 0; j < 2; ++j) raw[r][j] = *(const u32x4*)(xb + (size_t)m * DM + 512 * j + 8 * F.lane);
            rs[r] = row_rs(ss, m); }
#pragma unroll
        for (int r = 0; r < 4; ++r) { const int m = rbase + 256 * (k0 + r);
#pragma unroll
            for (int j = 0; j < 2; ++j) { f32x4 v0, v1; unpack8(raw[r][j], v0, v1);
                __builtin_nontemporal_store(v0 * rs[r] * gv[j][0], (f32x4*)(out + (size_t)m * DM + 512 * j + 8 * F.lane));
                __builtin_nontemporal_store(v1 * rs[r] * gv[j][1], (f32x4*)(out + (size_t)m * DM + 512 * j + 8 * F.lane + 4)); } }
    }
}
__device__ __forceinline__ void rope_tables(const Frame& F, float* rope) {
    const float invf[8] = {1.0f, 0.1939227432012558f, 0.03760603070259094f, 0.007292664609849453f, 0.0014142135623842478f, 0.00027424818836152554f, 5.318296098266728e-05f, 1.0313386155758053e-05f};
    for (int idx = blockIdx.x * NTHR + F.tid; idx < SEQ * 8; idx += F.G * NTHR) {
        const int pos = idx >> 3, i = idx & 7;
        float fi = invf[0];
#pragma unroll
        for (int k = 1; k < 8; ++k) fi = (i == k) ? invf[k] : fi;
        const float ang = (float)pos * fi;
        const double rev = (double)ang * 0.15915494309189535; const float fr = (float)(rev - __builtin_rint(rev));
        rope[idx] = __builtin_amdgcn_cosf(fr); rope[SEQ * 8 + idx] = __builtin_amdgcn_sinf(fr);
    }
}

struct MixP { const bf16 *GLU, *U, *SV, *K; bf16 *YA, *YB; float* KMEAN;
              const float *conv_w, *conv_b, *cln_g, *cln_b, *sln_g, *sln_b, *sgu_w, *sgu_b; };

__device__ __forceinline__ void conv_item(const Frame& F, const MixP& P, int ci, const int mode) {
    bf16* in_t = (bf16*)F.lds;
    float* out_t = (float*)(F.lds + 63488);
    const int t0 = ci * 32, tin = t0 & (SEQ - 1), tid = F.tid;
    const int cp = tid & 255, th = tid >> 8;
    f32x2 w2[31];
#pragma unroll
    for (int k = 0; k < 31; ++k) w2[k] = *(const f32x2*)(P.conv_w + k * CW + 2 * cp);
    const f32x2 bb = *(const f32x2*)(P.conv_b + 2 * cp);
    unsigned kv[16];
#pragma unroll
    for (int i = 0; i < 16; ++i) kv[i] = (mode != 2) ? *(const unsigned*)(P.K + (size_t)(t0 + th * 16 + i) * CW + 2 * cp) : 0u;
    if (mode == 1) { float k0 = 0.f, k1 = 0.f;
#pragma unroll
        for (int i = 0; i < 16; ++i) { k0 += bflo(kv[i]); k1 += bfhi(kv[i]); }
        *(f32x2*)(P.KMEAN + (size_t)(ci * 2 + th) * CW + 2 * cp) = (f32x2){k0, k1}; return; }
#pragma unroll 1
    for (int hb = 0; hb < 2; ++hb) {
        u32x4 tv[4];
#pragma unroll
        for (int p = 0; p < 4; ++p) { const int idx = tid + (hb * 4 + p) * NTHR, r = idx >> 6, ch = idx & 63; tv[p] = (u32x4){0u, 0u, 0u, 0u};
            if (idx < 62 * 64 && tin - 30 + r >= 0) tv[p] = *(const u32x4*)(P.GLU + arena_off(t0 - 30 + r) + ch * 8); }
#pragma unroll
        for (int p = 0; p < 4; ++p) { const int idx = tid + (hb * 4 + p) * NTHR, r = idx >> 6, ch = idx & 63; if (idx < 62 * 64) *(u32x4*)(in_t + r * CW + ch * 8) = tv[p]; }
    }
    if (mode != 2) { float k0 = 0.f, k1 = 0.f;
#pragma unroll
      for (int i = 0; i < 16; ++i) { k0 += bflo(kv[i]); k1 += bfhi(kv[i]); }
      *(f32x2*)(P.KMEAN + (size_t)(ci * 2 + th) * CW + 2 * cp) = (f32x2){k0, k1}; }
    __syncthreads();
    {
#pragma unroll 1
        for (int rd = 0; rd < 2; ++rd) {
            const int tb = th * 16 + rd * 8; f32x2 x2[38];
#pragma unroll
            for (int r = 0; r < 38; ++r) { const unsigned uv = *(const unsigned*)(in_t + (tb + r) * CW + 2 * cp); x2[r] = (f32x2){bflo(uv), bfhi(uv)}; }
#pragma unroll
            for (int t = 0; t < 8; ++t) { f32x2 a = bb;
#pragma unroll
                for (int k = 0; k < 31; ++k) a = w2[k] * x2[t + k] + a;
                *(f32x2*)(out_t + (tb + t) * CW + 2 * cp) = a; }
        }
    }
    __syncthreads();
    {
        const int lane = F.lane; f32x4 g0 = *(const f32x4*)(P.cln_g + lane * 8), g1 = *(const f32x4*)(P.cln_g + lane * 8 + 4), b0 = *(const f32x4*)(P.cln_b + lane * 8), b1 = *(const f32x4*)(P.cln_b + lane * 8 + 4);
#pragma unroll
        for (int i = 0; i < 4; ++i) { const int t = F.wave * 4 + i;
            f32x4 v0 = *(const f32x4*)(out_t + t * CW + lane * 8), v1 = *(const f32x4*)(out_t + t * CW + lane * 8 + 4);
            const float mean = wave_sum((v0.x + v0.y) + (v0.z + v0.w) + (v1.x + v1.y) + (v1.z + v1.w)) * (1.f / CW);
            v0 = v0 - mean; v1 = v1 - mean;
            const float var = wave_sum((v0.x * v0.x + v0.y * v0.y) + (v0.z * v0.z + v0.w * v0.w) + (v1.x * v1.x + v1.y * v1.y) + (v1.z * v1.z + v1.w * v1.w)) * (1.f / CW);
            const float rstd = 1.0f / sqrtf(var + EPS);
            f32x4 y0 = v0 * rstd * g0 + b0, y1 = v1 * rstd * g1 + b1;
#pragma unroll
            for (int e = 0; e < 4; ++e) { y0[e] = y0[e] * sigm(y0[e]); y1[e] = y1[e] * sigm(y1[e]); }
            store8(P.YA + (size_t)(t0 + t) * CW + lane * 8, y0, y1); }
    }
    __syncthreads();
}
__device__ __forceinline__ void sgu_item(const Frame& F, const MixP& P, int si) {
    const int chunk = si >> 1, gp = si & 1, tb = chunk * 128, lane = F.lane, wave = F.wave;
    bf16* vT = (bf16*)F.lds;
    const int t0 = wave * 16, fr = lane & 15, fq = lane >> 4, t = t0 + fr;
    {
        const f32x4 g0 = *(const f32x4*)(P.sln_g + lane * 8), g1 = *(const f32x4*)(P.sln_g + lane * 8 + 4), b0 = *(const f32x4*)(P.sln_b + lane * 8), b1 = *(const f32x4*)(P.sln_b + lane * 8 + 4);
        u32x4 raw[16];
#pragma unroll
        for (int i = 0; i < 16; ++i) raw[i] = *(const u32x4*)(P.SV + (size_t)(tb + wave * 16 + i) * CW + lane * 8);
#pragma unroll
        for (int i = 0; i < 16; ++i) { const int s = wave * 16 + i; f32x4 v0, v1; unpack8(raw[i], v0, v1);
            const float mean = wave_sum((v0.x + v0.y) + (v0.z + v0.w) + (v1.x + v1.y) + (v1.z + v1.w)) * (1.f / CW);
            v0 = v0 - mean; v1 = v1 - mean;
            const float var = wave_sum((v0.x * v0.x + v0.y * v0.y) + (v0.z * v0.z + v0.w * v0.w) + (v1.x * v1.x + v1.y * v1.y) + (v1.z * v1.z + v1.w * v1.w)) * (1.f / CW);
            const float rstd = 1.0f / sqrtf(var + EPS);
            const f32x4 y0 = v0 * rstd * g0 + b0, y1 = v1 * rstd * g1 + b1;
            if ((lane >> 5) == gp) { bf16* d = vT + (((lane >> 4) & 1) * 128 + (lane & 15) * 8) * 136 + s;
#pragma unroll
                for (int e = 0; e < 4; ++e) { d[e * 136] = (bf16)(pk2(y0[e], 0.f) & 0xffffu); d[(4 + e) * 136] = (bf16)(pk2(y1[e], 0.f) & 0xffffu); } } }
    }
    __syncthreads();
#pragma unroll 1
    for (int gi = 0; gi < 2; ++gi) {
        const int g = gp * 2 + gi; const bf16* vTg = vT + gi * 128 * 136;
        const float* Wrow = P.sgu_w + ((size_t)g * 128 + t) * 128;
        f32x4 wa[4], wb[4];
#pragma unroll
        for (int ks = 0; ks < 4; ++ks) { wa[ks] = (f32x4){0.f, 0.f, 0.f, 0.f}; wb[ks] = wa[ks]; if (32 * ks < t0 + 16) { wa[ks] = *(const f32x4*)(Wrow + 32 * ks + 8 * fq); wb[ks] = *(const f32x4*)(Wrow + 32 * ks + 8 * fq + 4); } }
        u32x2 ur[8];
#pragma unroll
        for (int cb = 0; cb < 8; ++cb) ur[cb] = *(const u32x2*)(P.U + arena_off(tb + t) + g * 128 + 16 * cb + 4 * fq);
        const float bs = P.sgu_b[g * 128 + t];
        f32x4 acc[8];
#pragma unroll
        for (int cb = 0; cb < 8; ++cb) acc[cb] = (f32x4){0.f, 0.f, 0.f, 0.f};
#pragma unroll
        for (int ks = 0; ks < 4; ++ks) if (32 * ks < t0 + 16) { const int sb = 32 * ks + 8 * fq;
            float wv[8] = {wa[ks].x, wa[ks].y, wa[ks].z, wa[ks].w, wb[ks].x, wb[ks].y, wb[ks].z, wb[ks].w};
#pragma unroll
            for (int e = 0; e < 8; ++e) wv[e] = (sb + e <= t) ? wv[e] : 0.f;
            u32x4 wp; wp.x = pk2(wv[0], wv[1]); wp.y = pk2(wv[2], wv[3]); wp.z = pk2(wv[4], wv[5]); wp.w = pk2(wv[6], wv[7]);
            const bf16x8 wf = __builtin_bit_cast(bf16x8, wp);
#pragma unroll
            for (int cb = 0; cb < 8; ++cb) { const bf16x8 vf = *(const bf16x8*)(vTg + (16 * cb + fr) * 136 + sb); acc[cb] = __builtin_amdgcn_mfma_f32_16x16x32_bf16(vf, wf, acc[cb], 0, 0, 0); } }
#pragma unroll
        for (int cb = 0; cb < 8; ++cb) { const size_t off = (size_t)(tb + t) * CW + g * 128 + 16 * cb + 4 * fq;
            u32x2 o; o.x = pk2(bflo(ur[cb].x) * (acc[cb][0] + bs), bfhi(ur[cb].x) * (acc[cb][1] + bs)); o.y = pk2(bflo(ur[cb].y) * (acc[cb][2] + bs), bfhi(ur[cb].y) * (acc[cb][3] + bs));
            *(u32x2*)(P.YB + off) = o; }
    }
    __syncthreads();
}
__device__ __forceinline__ bool mix_deferred(int bx) { return (bx >> 3) == 0 && ((bx & 7) & 3) != 0; }
__device__ __forceinline__ void mix_phase(const Frame& F, const MixP& P) {
    const int cls = F.bx & 7, rank = F.bx >> 3;
    if (mix_deferred(F.bx)) conv_item(F, P, 64 * cls + rank, 1); else conv_item(F, P, 64 * cls + rank, 0);
    conv_item(F, P, 64 * cls + 32 + rank, 0);
    sgu_item(F, P, 32 * cls + rank);
}
}

#ifndef PHM
#define PHM 0xFFFF
#endif
#ifndef REP_SYNC
#define REP_SYNC 1
#endif
#ifndef REP_NORM
#define REP_NORM 1
#endif
#ifndef REP_MIX
#define REP_MIX 1
#endif
#ifndef REP_WI
#define REP_WI 1
#endif
#ifndef REP_WO
#define REP_WO 1
#endif
#ifndef REP_WIN
#define REP_WIN 1
#endif
#ifndef REP_BR
#define REP_BR 1
#endif
#ifndef REP_CVT
#define REP_CVT 1
#endif
#ifndef REP_ATT
#define REP_ATT 1
#endif
#define GSYNC() do { _Pragma("unroll 1") for (int rs_ = 0; rs_ < REP_SYNC; ++rs_) xb::xcd_barrier(xbar); } while (0)
#define LSYNC() do { if (local_ok) xb::xcd_barrier_local(xbar); else xb::xcd_barrier(xbar); } while (0)
struct Args { const float* in[21]; float* out; unsigned char* ws; };
typedef __attribute__((address_space(4))) const unsigned char* kargp_t;
__device__ __forceinline__ const float* ldarg(int i) {
#if defined(__HIP_DEVICE_COMPILE__)
    kargp_t p = (kargp_t)__builtin_amdgcn_kernarg_segment_ptr(); asm volatile("" : "+s"(p)); return (const float*)*(__attribute__((address_space(4))) const unsigned long long*)(p + 8 * i);
#else
    return nullptr;
#endif
}
#define INP(i) ldarg(i)
#define TAIL_FRAME(FT, ntiles) mk::Frame FT = F; const int R_ = (ntiles) % F.G; const bool tail_idle_ = R_ > 0 && F.bx >= R_; FT.gw = (F.bx - R_) * mk::NWV + F.wave; FT.ngw = (F.G - R_) * mk::NWV;
template <class Sched> __device__ __forceinline__ void preload_rs(const Sched& S, const float* SS, float* rsl) {
    int t = threadIdx.x; asm volatile("" : "+v"(t)); pg8::Unit u;
    for (int i = 0; i < 8 && S.next(i, u); ++i) if (t < 256) rsl[i * 256 + t] = mk::row_rs(SS, u.pm * 256 + t);
    __syncthreads();
}
template <class Sched> __device__ __forceinline__ void preload_gb(const Sched& S, const float* gate_b, float* gbl) {
    int t = threadIdx.x; asm volatile("" : "+v"(t)); pg8::Unit u;
    for (int i = 0; i < 8 && S.next(i, u); ++i) if (t < 256 && u.pn >= 14) gbl[i * 256 + t] = gate_b[(u.pn - 14) * 256 + t];
}
#define OUTP() ((float*)ldarg(21))
#define WSB(off) ((mk::bf16*)((unsigned char*)ldarg(22) + (off)))
#define WSF(off) ((float*)((unsigned char*)ldarg(22) + (off)))
#define OB(off) ((mk::bf16*)((unsigned char*)ldarg(21) + (off)))
__global__ void __launch_bounds__(512, 2) mk_fwd(Args a) {
    using namespace mk;
    extern __shared__ __attribute__((aligned(16))) unsigned char lds[];
    cg::grid_group grid = cg::this_grid();
    Frame F; F.lds = lds; F.tid = threadIdx.x; F.lane = F.tid & 63; F.wave = __builtin_amdgcn_readfirstlane(F.tid >> 6); F.G = gridDim.x;
    F.gw = blockIdx.x * NWV + F.wave; F.ngw = F.G * NWV;
    PG8_LAS unsigned char* ldsA = (PG8_LAS unsigned char*)lds;
    if (F.tid < 32) ((PG8_LAS unsigned*)(ldsA + 131072))[F.tid] = 0u;
    __syncthreads();
    if (blockIdx.x == 0) {
        unsigned* w0 = (unsigned*)ldarg(22);
        for (int i = F.tid; i < 16384; i += NTHR) __hip_atomic_store(w0 + i, 0u, __ATOMIC_RELAXED, __HIP_MEMORY_SCOPE_AGENT);
        asm volatile("s_waitcnt vmcnt(0)" ::: "memory"); __threadfence();
    }
    grid.sync();
    const xb::XcdBarrier xbar = xb::xcd_barrier_post((unsigned*)ldarg(22) + 1024, (volatile PG8_LAS unsigned*)(ldsA + 131072) + 8);
    xb::xcd_local_post(xbar);

    { int cb_ = 0;
      cvt_weight(F, INP(2), DM, 2 * FF, WSB(WS_FALT_WI), 1, INP(1), cb_);
      cvt_weight(F, INP(3), FF, DM, WSB(WS_FALT_WO), 0, nullptr, cb_);
      cvt_weight(F, INP(5), DM, NIN, WSB(WS_WIN), 2, INP(4), cb_); }
    prep_rows(F, INP(0), WSB(WS_XN), WSF(WS_SS));
    GSYNC();
    const bool local_ok = xb::xcd_local_ok(xbar);
#pragma unroll 1
    for (int l = 0; l < NLAYER; ++l) {
#pragma unroll 1
        for (int f = 0; f < 2; ++f) {
            const bool first = (l == 0 && f == 0);
#pragma unroll 1
            for (int rw_ = 0; rw_ < REP_WI; ++rw_)
            { frame_refresh(F); pg8::Gemm g{WSB(WS_XN), WSB(f ? WS_WFI : WS_FALT_WI), TOK, 2 * FF, DM}; pg8::StaticOrder S; S.init(TOK, 2 * FF, F.G, F.bx); EpiSwiGLU E{(unsigned char*)ldarg(22), (const PG8_LAS float*)(ldsA + LDS_RS), 0}; preload_rs(S, WSF(WS_SS), (float*)(lds + LDS_RS));
              pg8::gemm_phase<EpiSwiGLU, pg8::StaticOrder, true, true>(ldsA, g, S, E); }
            { TAIL_FRAME(FT, (TOK / 256) * (2 * FF / 256))
              if (tail_idle_) { int cb_ = 0;
                  if (f == 0) cvt_weight(FT, INP(18) + (size_t)l * DM * 2 * FF, DM, 2 * FF, WSB(WS_WFI), 1, INP(17) + l * DM, cb_);
                  else if (l + 1 < NLAYER) cvt_weight(FT, INP(2) + (size_t)(l + 1) * DM * 2 * FF, DM, 2 * FF, WSB(WS_FALT_WI), 1, INP(1) + (l + 1) * DM, cb_); } }
            LSYNC();
            frame_refresh(F);
            { pg8::Gemm g{WSB(WS_ACT), WSB(f ? WS_WFO : WS_FALT_WO), TOK, DM, FF}; pg8::StaticOrder S; S.init(TOK, DM, F.G, F.bx);
              EpiResid E{0.5f, (unsigned char*)ldarg(22)};
              pg8::gemm_phase<EpiResid, pg8::StaticOrder, false, true>(ldsA, g, S, E); }
            if (f == 0) LSYNC(); else GSYNC();
            if (f == 0) {
#pragma unroll 1
                for (int ri_ = 0; ri_ < REP_WIN; ++ri_)
                frame_refresh(F);
                { pg8::Gemm g{WSB(WS_XN), WSB(WS_WIN), TOK, NIN, DM}; pg8::StaticOrder S; S.init(TOK, NIN, F.G, F.bx);
                  EpiWin E{(unsigned char*)ldarg(22), INP(15) + l * 3 * DM, (const PG8_LAS float*)(ldsA + LDS_RS), 0, (unsigned char*)ldarg(21)}; preload_gb(S, INP(15) + l * 3 * DM, (float*)(lds + LDS_GB)); preload_rs(S, WSF(WS_SS), (float*)(lds + LDS_RS));
                  pg8::gemm_phase<EpiWin, pg8::StaticOrder, true, true>(ldsA, g, S, E); }
                { TAIL_FRAME(FT, (TOK / 256) * (NIN / 256))
                  if (tail_idle_) { int cb_ = 0;
                      cvt_weight(FT, INP(19) + (size_t)l * FF * DM, FF, DM, WSB(WS_WFO), 0, nullptr, cb_);
#pragma unroll 1
                      for (int i = 0; i < 3; ++i) cvt_weight(FT, INP(14) + ((size_t)l * 3 + i) * CW * DM, CW, DM, WSB(WS_WBR) + (size_t)i * DM * CW, 0, nullptr, cb_);
                      cvt_weight(FT, INP(16) + (size_t)l * DM * DM, DM, DM, WSB(WS_WOUT), 0, nullptr, cb_); } }
                LSYNC();
#pragma unroll 1
                for (int rm_ = 0; rm_ < REP_MIX; ++rm_) {
                frame_refresh(F);
                { MixP P{WSB(WS_GLU), WSB(WS_U), OB(48 * mk::MiB), WSB(WS_K), OB(0), OB(16 * mk::MiB), WSF(WS_KMEAN), INP(6) + l * 31 * CW, INP(7) + l * CW, INP(8) + l * CW, INP(9) + l * CW, INP(10) + l * CW, INP(11) + l * CW, INP(12) + (size_t)l * 4 * 128 * 128, INP(13) + l * 4 * 128};
                  mix_phase(F, P); } }
                GSYNC();
                frame_refresh(F);
                if (l + 1 < NLAYER) {
                    int cb_ = 0;
                    cvt_weight(F, INP(3) + (size_t)(l + 1) * FF * DM, FF, DM, WSB(WS_FALT_WO), 0, nullptr, cb_);
                    cvt_weight(F, INP(5) + (size_t)(l + 1) * DM * NIN, DM, NIN, WSB(WS_WIN), 2, INP(4) + (l + 1) * DM, cb_);
                }
                if (mix_deferred(F.bx)) { MixP P{WSB(WS_GLU), WSB(WS_U), OB(48 * mk::MiB), WSB(WS_K), OB(0), OB(16 * mk::MiB), WSF(WS_KMEAN), INP(6) + l * 31 * CW, INP(7) + l * CW, INP(8) + l * CW, INP(9) + l * CW, INP(10) + l * CW, INP(11) + l * CW, INP(12) + (size_t)l * 4 * 128 * 128, INP(13) + l * 4 * 128};
                    conv_item(F, P, 64 * (F.bx & 7), 2); }
                __syncthreads();
                { const attn_body::AttnTensors AT{(const attn_body::bf16*)OB(32 * mk::MiB), (const attn_body::bf16*)WSB(WS_K), (const attn_body::bf16*)WSB(WS_V), (attn_body::bf16*)OB(32 * mk::MiB), WSF(WS_KMEAN)};
                  const attn_body::StaticOrder S((int)F.G, F.bx);
                  attn_body::attn_phase<attn_body::StaticOrder>((char*)lds, AT, S); }
                GSYNC();
                frame_refresh(F);
                { pg8::Gemm g{OB(0), WSB(WS_WBR), 3 * TOK, 3 * DM, CW}; BranchOrder S; S.base.init(TOK, DM, F.G, F.bx); EpiBranch E{(const unsigned char*)WSB(WS_GATES), WSB(WS_MERGED)};
                  pg8::gemm_phase<EpiBranch, BranchOrder, true, true>(ldsA, g, S, E); }
                LSYNC();
                frame_refresh(F);
                { pg8::Gemm g{WSB(WS_MERGED), WSB(WS_WOUT), TOK, DM, DM}; pg8::StaticOrder S; S.init(TOK, DM, F.G, F.bx);
                  EpiResid E{1.0f, (unsigned char*)ldarg(22)};
                  pg8::gemm_phase<EpiResid, pg8::StaticOrder, false, true>(ldsA, g, S, E); }
                LSYNC();
            }
        }
    }
    frame_refresh(F);
    final_norm_rows(F, WSB(WS_XN), WSF(WS_SS), OUTP(), INP(20));
}

extern "C" void kernel_launch(void* const* d_in, const int* in_sizes, int n_in, void* d_out, int out_size, void* d_ws, size_t ws_size, hipStream_t stream) {
    static int grid = 0;
    if (grid == 0) {
        if (n_in != 21 || out_size != mk::TOK * mk::DM || ws_size < mk::WS_END) { fprintf(stderr, "kernel_launch: unexpected shapes (n_in %d out %d ws %zu)\n", n_in, out_size, ws_size); grid = -1; return; }
        int dev = 0, cus = 0, per_cu = 0;
        hipGetDevice(&dev); hipDeviceGetAttribute(&cus, hipDeviceAttributeMultiprocessorCount, dev);
        if (hipFuncSetAttribute((const void*)mk_fwd, hipFuncAttributeMaxDynamicSharedMemorySize, mk::LDS_BYTES) != hipSuccess) { fprintf(stderr, "kernel_launch: hipFuncSetAttribute failed\n"); grid = -1; return; }
        if (hipOccupancyMaxActiveBlocksPerMultiprocessor(&per_cu, (const void*)mk_fwd, mk::NTHR, mk::LDS_BYTES) != hipSuccess || per_cu < 1) { fprintf(stderr, "kernel_launch: occupancy query failed (%d)\n", per_cu); grid = -1; return; }
        grid = cus * (per_cu > 1 ? 1 : per_cu);
        if (grid != 256) { fprintf(stderr, "kernel_launch: built for a 256-CU device (grid %d)\n", grid); grid = -1; return; }
    }
    if (grid < 0) return;
    Args a{};
    for (int i = 0; i < 21; ++i) a.in[i] = (const float*)d_in[i];
    a.out = (float*)d_out; a.ws = (unsigned char*)d_ws;
    void* args[] = {&a};
    hipError_t e = hipLaunchCooperativeKernel((const void*)mk_fwd, dim3(grid), dim3(mk::NTHR), args, mk::LDS_BYTES, stream);
    if (e != hipSuccess) fprintf(stderr, "cooperative launch failed: %s (grid %d)\n", hipGetErrorString(e), grid);
}
```

```cpp
#include <hip/hip_runtime.h>
#include <hip/hip_cooperative_groups.h>
#include <hip/hip_bf16.h>
#include <cstdio>
#include <cstdint>
#include <cmath>
namespace cg = cooperative_groups;

namespace pg8 {
#define PG8_LAS __attribute__((address_space(3)))
typedef unsigned short bf16_t;
typedef short bf16x8 __attribute__((ext_vector_type(8)));
typedef float f32x4 __attribute__((ext_vector_type(4)));
typedef unsigned u32x4 __attribute__((ext_vector_type(4)));
constexpr int BM = 256, BK = 64, HALF = 128, HTB = HALF * BK * 2  , STAGE_BYTES = 8 * HTB, NXCD = 8, WGM = 8;

__host__ __device__ __forceinline__ int lds_byte(int r, int c) { const int st = (r >> 4) * 2 + (c >> 5), rr = r & 15, cc = c & 31, ob = rr * 64 + cc * 2; return st * 1024 + (ob ^ (((ob >> 9) & 1) << 5)); }
__host__ __device__ __forceinline__ void stage_rc(int b, int& R, int& C) { const int st = b / 1024, sb = b % 1024, swz = sb ^ (((sb >> 9) & 1) << 5); R = (st >> 1) * 16 + swz / 64; C = (st & 1) * 32 + (swz % 64) / 2; }
__host__ __device__ __forceinline__ int perm32(int rho) { const int n = rho >> 4, i = rho & 15; return 8 * (i >> 2) + 4 * n + (i & 3); }

struct Unit { int pm, pn; };
struct Gemm { const bf16_t* A; const bf16_t* Bt; int M, N, K; };

struct StaticOrder {
    int nM, nN, nwg, G, c;
    __host__ __device__ void init(int M, int N, int G_, int c_) { nM = M / BM; nN = N / BM; nwg = nM * nN; G = G_; c = c_; }
    __host__ __device__ bool next(int i, Unit& u) const {
        const long L = (long)i * G + c; if (L >= nwg) return false;
        int wgid = (int)L; { const int q = nwg / NXCD, r = nwg % NXCD, xcd = wgid % NXCD, off = wgid / NXCD; wgid = (xcd < r ? xcd * (q + 1) : r * (q + 1) + (xcd - r) * q) + off; }
        const int nig = WGM * nN, gid = wgid / nig, fm = gid * WGM, gsz = (nM - fm) < WGM ? (nM - fm) : WGM;
        u.pm = fm + ((wgid % nig) % gsz); u.pn = (wgid % nig) / gsz; return true;
    }
    __device__ __forceinline__ void a_ready(const Unit&) const {}
    __device__ __forceinline__ void done(const Unit&) const {}
};

__device__ __forceinline__ unsigned cvt_pk_bf16(float lo, float hi) { unsigned r; asm volatile("v_cvt_pk_bf16_f32 %0, %1, %2" : "=v"(r) : "v"(lo), "v"(hi)); return r; }
typedef float f32x2 __attribute__((ext_vector_type(2)));
template <class Epi, class Sched, bool ALIGN_EPI = false, bool SP2 = false>
__device__ __forceinline__ void gemm_phase(PG8_LAS unsigned char* lds, const Gemm g, const Sched& S, const Epi& E) {
    int tid_ = threadIdx.x; asm volatile("" : "+v"(tid_));
    const int tid = tid_, wid = __builtin_amdgcn_readfirstlane(tid >> 6), lane = tid & 63, wr = wid >> 2, wc = wid & 3, fr = lane & 15, fq = lane >> 4;
    const int K = g.K, nt = K / BK;
    unsigned voffA[2], voffB[2];
#pragma unroll
    for (int i = 0; i < 2; ++i) { int R, C; stage_rc(tid * 16 + i * 8192, R, C); const int Rb = Epi::PERM ? ((R & ~31) + perm32(R & 31)) : R;
        voffA[i] = (unsigned)(R * K + C) * 2u; voffB[i] = (unsigned)(Rb * K + C) * 2u; }
    const size_t kstep = (size_t)(BK * 2);
    const size_t hstep = (size_t)HALF * K * 2;
    const size_t tstep = 2 * hstep;
    const unsigned ldsw = (unsigned)wid * 1024u;
    const int aoff = lds_byte(wr * 64 + fr, fq * 8), boff = lds_byte(wc * 32 + fr, fq * 8);
#define PG8_SA(b, h) (((b) * 2 + (h)) * HTB)
#define PG8_SB(b, h) ((4 + (b) * 2 + (h)) * HTB)
#define PG8_STAGE(bufoff, gbase, voff) do { _Pragma("unroll") for (int _i = 0; _i < 2; ++_i) \
        __builtin_amdgcn_global_load_lds((const unsigned*)((const char*)(gbase) + (voff)[_i]), (PG8_LAS unsigned*)(lds + (bufoff) + ldsw + _i * 8192), 16, 0, 0); } while (0)
#define PG8_LDA(dst, b, h) do { _Pragma("unroll") for (int m = 0; m < 4; ++m) _Pragma("unroll") for (int k = 0; k < 2; ++k) dst[m][k] = *(const PG8_LAS bf16x8*)(lds + PG8_SA(b, h) + aoff + m * 2048 + k * 1024); } while (0)
#define PG8_LDB(dst, b, h) do { _Pragma("unroll") for (int n = 0; n < 2; ++n) _Pragma("unroll") for (int k = 0; k < 2; ++k) dst[n][k] = *(const PG8_LAS bf16x8*)(lds + PG8_SB(b, h) + boff + n * 2048 + k * 1024); } while (0)
#define PG8_MMA(ai, bj, At, Bt) do { __builtin_amdgcn_s_setprio(1); _Pragma("unroll") for (int m = 0; m < 4; ++m) _Pragma("unroll") for (int n = 0; n < 2; ++n) _Pragma("unroll") for (int k = 0; k < 2; ++k) \
        acc[ai][bj][m][n] = __builtin_amdgcn_mfma_f32_16x16x32_bf16(Bt[n][k], At[m][k], acc[ai][bj][m][n], 0, 0, 0); __builtin_amdgcn_s_setprio(0); } while (0)
#define PG8_WAIT_V(n) asm volatile("s_waitcnt vmcnt(" #n ")" ::: "memory")
#define PG8_WAIT_L(n) asm volatile("s_waitcnt lgkmcnt(" #n ")" ::: "memory")
#define PG8_BAR __builtin_amdgcn_s_barrier()
#define PG8_SCHED __builtin_amdgcn_sched_barrier(0)
    Unit cur, nxt; int ui = 0;
    if (!S.next(0, cur)) return;
    f32x4 acc[2][2][4][2];
#pragma unroll
    for (int a = 0; a < 2; ++a)
#pragma unroll
        for (int b = 0; b < 2; ++b)
#pragma unroll
            for (int m = 0; m < 4; ++m)
#pragma unroll
                for (int n = 0; n < 2; ++n) acc[a][b][m][n] = (f32x4){0.f, 0.f, 0.f, 0.f};
    bf16x8 At[4][2], B0[2][2], B1[2][2];
    const char* cA = (const char*)g.A + (size_t)cur.pm * tstep; const char* cB = (const char*)g.Bt + (size_t)cur.pn * tstep;
    S.a_ready(cur);
    if constexpr (SP2) {
        PG8_STAGE(PG8_SB(0, 0), cB, voffB); PG8_STAGE(PG8_SB(0, 1), cB + hstep, voffB); PG8_STAGE(PG8_SA(0, 0), cA, voffA); PG8_STAGE(PG8_SA(0, 1), cA + hstep, voffA);
        if (wr == 1) PG8_BAR;
        PG8_WAIT_V(2); PG8_BAR;
        PG8_STAGE(PG8_SB(1, 0), cB + kstep, voffB); PG8_STAGE(PG8_SA(1, 0), cA + kstep, voffA); PG8_STAGE(PG8_SB(1, 1), cB + hstep + kstep, voffB);
        PG8_WAIT_V(6); PG8_BAR;
    } else {
        PG8_STAGE(PG8_SB(0, 0), cB, voffB); PG8_STAGE(PG8_SA(0, 0), cA, voffA); PG8_STAGE(PG8_SB(0, 1), cB + hstep, voffB); PG8_STAGE(PG8_SA(0, 1), cA + hstep, voffA);
        if (wr == 1) PG8_BAR;
        PG8_WAIT_V(4); PG8_BAR;
        PG8_STAGE(PG8_SB(1, 0), cB + kstep, voffB); PG8_STAGE(PG8_SA(1, 0), cA + kstep, voffA); PG8_STAGE(PG8_SB(1, 1), cB + hstep + kstep, voffB);
        PG8_WAIT_V(6); PG8_BAR;
    }
    for (;;) {
        const bool has_next = S.next(ui + 1, nxt);
        const char* nA = has_next ? (const char*)g.A + (size_t)nxt.pm * tstep : cA; const char* nB = has_next ? (const char*)g.Bt + (size_t)nxt.pn * tstep : cB;
        for (int t = 0; t < nt; t += 2) {
            const bool last = (t == nt - 2);
            const char* a1 = cA + (size_t)(t + 1) * kstep;
            const char* a2 = last ? nA : cA + (size_t)(t + 2) * kstep; const char* b2 = last ? nB : cB + (size_t)(t + 2) * kstep;
            const char* a3 = a2 + kstep; const char* b3 = b2 + kstep;
            if (last && has_next) S.a_ready(nxt);
            if constexpr (SP2) {
            PG8_LDB(B0, 0, 0); PG8_LDB(B1, 0, 1); PG8_SCHED; PG8_LDA(At, 0, 0); PG8_STAGE(PG8_SA(1, 1), a1 + hstep, voffA);
            PG8_WAIT_V(8); PG8_WAIT_L(0); PG8_BAR; PG8_MMA(0, 0, At, B0); PG8_MMA(0, 1, At, B1); PG8_BAR; PG8_SCHED;
            PG8_LDA(At, 0, 1); PG8_STAGE(PG8_SB(0, 0), b2, voffB); PG8_STAGE(PG8_SB(0, 1), b2 + hstep, voffB); PG8_STAGE(PG8_SA(0, 0), a2, voffA);
            PG8_WAIT_V(8); PG8_WAIT_L(0); PG8_BAR; PG8_MMA(1, 0, At, B0); PG8_MMA(1, 1, At, B1); PG8_BAR; PG8_SCHED;
            PG8_LDB(B0, 1, 0); PG8_LDB(B1, 1, 1); PG8_SCHED; PG8_LDA(At, 1, 0); PG8_STAGE(PG8_SA(0, 1), a2 + hstep, voffA);
            PG8_WAIT_V(8); PG8_WAIT_L(0); PG8_BAR; PG8_MMA(0, 0, At, B0); PG8_MMA(0, 1, At, B1); PG8_BAR; PG8_SCHED;
            PG8_LDA(At, 1, 1); PG8_STAGE(PG8_SB(1, 0), b3, voffB); PG8_STAGE(PG8_SB(1, 1), b3 + hstep, voffB); PG8_STAGE(PG8_SA(1, 0), a3, voffA);
            PG8_WAIT_V(8); PG8_WAIT_L(0); PG8_BAR; PG8_MMA(1, 0, At, B0); PG8_MMA(1, 1, At, B1); PG8_BAR; PG8_SCHED;
            } else {
            PG8_LDB(B0, 0, 0); PG8_SCHED; PG8_LDA(At, 0, 0); PG8_STAGE(PG8_SA(1, 1), a1 + hstep, voffA);
            PG8_WAIT_L(8); PG8_BAR; PG8_WAIT_L(0); PG8_MMA(0, 0, At, B0); PG8_BAR; PG8_SCHED;
            PG8_LDB(B1, 0, 1); PG8_STAGE(PG8_SB(0, 0), b2, voffB);
            PG8_BAR; PG8_WAIT_L(0); PG8_MMA(0, 1, At, B1); PG8_BAR;
            PG8_LDA(At, 0, 1); PG8_STAGE(PG8_SA(0, 0), a2, voffA);
            PG8_BAR; PG8_WAIT_L(0); PG8_MMA(1, 0, At, B0); PG8_BAR; PG8_SCHED;
            PG8_STAGE(PG8_SB(0, 1), b2 + hstep, voffB);
            PG8_WAIT_V(6); PG8_BAR; PG8_MMA(1, 1, At, B1); PG8_BAR;
            PG8_LDB(B0, 1, 0); PG8_SCHED; PG8_LDA(At, 1, 0); PG8_STAGE(PG8_SA(0, 1), a2 + hstep, voffA);
            PG8_WAIT_L(8); PG8_BAR; PG8_WAIT_L(0); PG8_MMA(0, 0, At, B0); PG8_BAR; PG8_SCHED;
            PG8_LDB(B1, 1, 1); PG8_STAGE(PG8_SB(1, 0), b3, voffB);
            PG8_BAR; PG8_WAIT_L(0); PG8_MMA(0, 1, At, B1); PG8_BAR;
            PG8_LDA(At, 1, 1); PG8_STAGE(PG8_SA(1, 0), a3, voffA);
            PG8_BAR; PG8_WAIT_L(0); PG8_MMA(1, 0, At, B0); PG8_BAR; PG8_SCHED;
            PG8_STAGE(PG8_SB(1, 1), b3 + hstep, voffB);
            PG8_WAIT_V(6); PG8_BAR; PG8_MMA(1, 1, At, B1); PG8_BAR;
            }
        }
        if constexpr (ALIGN_EPI) { if (wr == 0) PG8_BAR; }
        if constexpr (!Epi::AFTER_DRAIN) { if constexpr (Epi::KEEP_ACC) E.inplace(acc, cur, wr, wc, fr, fq); else E(acc, cur, wr, wc, fr, fq);
#ifdef DUP_EPI
            if constexpr (Epi::DUP) { asm volatile("" ::: "memory"); --E.ui; E(acc, cur, wr, wc, fr, fq); }
#endif
            S.done(cur); }
        if (!has_next) break;
        bool keep_ = false; if constexpr (Epi::KEEP_ACC) keep_ = E.keep(cur);
        if (!keep_) {
#pragma unroll
        for (int a = 0; a < 2; ++a)
#pragma unroll
            for (int b = 0; b < 2; ++b)
#pragma unroll
                for (int m = 0; m < 4; ++m)
#pragma unroll
                    for (int n = 0; n < 2; ++n) acc[a][b][m][n] = (f32x4){0.f, 0.f, 0.f, 0.f};
        }
        cur = nxt; cA = nA; cB = nB; ++ui;
        if constexpr (ALIGN_EPI) { if (wr == 1) PG8_BAR; }
    }
    PG8_WAIT_V(0);
    if constexpr (!ALIGN_EPI) { if (wr == 0) PG8_BAR; }
    PG8_BAR;
    if constexpr (Epi::AFTER_DRAIN) { E.fused(acc, cur, wr, wc, fr, fq, lds, wid, lane); S.done(cur); }
#undef PG8_SA
#undef PG8_SB
#undef PG8_STAGE
#undef PG8_LDA
#undef PG8_LDB
#undef PG8_MMA
#undef PG8_WAIT_V
#undef PG8_WAIT_L
#undef PG8_BAR
#undef PG8_SCHED
}
}
namespace attn_body {
using bf16=__hip_bfloat16;
using bf16x8=__attribute__((ext_vector_type(8)))short;
using s16x4=__attribute__((ext_vector_type(4)))short;
using f32x16=__attribute__((ext_vector_type(16)))float;
using u32x4=__attribute__((ext_vector_type(4)))unsigned;
constexpr int BATCH=2,NHEAD=8,SEQ=8192,D=64,DM=NHEAD*D;
constexpr int NW=8,QBLK=32,QB=QBLK*NW,KVBLK=64,NQB=SEQ/QB;
constexpr int ATTN_PITCH=DM, ATTN_UNIT_ROWS=QB;
__device__ __forceinline__ int crow(int r,int hi){return (r&3)+8*(r>>2)+4*hi;}
#define SBAR() __builtin_amdgcn_sched_barrier(0)
__device__ __forceinline__ void cmask(f32x16&p0,f32x16&p1,int jb,int qrel,int hi){
  const float NEG=-INFINITY; int kb=64*jb+4*hi;
  #pragma unroll
  for(int r=0;r<16;++r){int kv=kb+(r&3)+8*(r>>2); if(kv>qrel)p0[r]=NEG; if(kv+32>qrel)p1[r]=NEG;}
}

constexpr int NSLOT=3, SLOTB=8192;
constexpr int LDS_K=0, LDS_V=NSLOT*SLOTB, LDS_WS=2*NSLOT*SLOTB, LDS_OST=LDS_WS+NW*64*4, LDS_KM=LDS_OST+NW*4096, LDS_BYTES=LDS_KM+32*64*4;
constexpr float C2=0.125f*1.4426950408889634f;
__device__ __forceinline__ void glds16(const void*gsrc,unsigned lds_dst){unsigned keep;
  asm volatile("s_mov_b32 %0, m0\n\ts_mov_b32 m0, %2\n\ts_nop 0\n\tglobal_load_lds_dwordx4 %1, off\n\ts_mov_b32 m0, %0":"=&s"(keep):"v"(gsrc),"s"(lds_dst):"memory");}
__device__ __forceinline__ float max3f(float a,float b,float c){float r;asm("v_max3_f32 %0, %1, %2, %3":"=v"(r):"v"(a),"v"(b),"v"(c));return r;}
__device__ __forceinline__ float max2f(float a,float b){float r;asm("v_max_f32_e32 %0, %1, %2":"=v"(r):"v"(a),"v"(b));return r;}
__device__ __forceinline__ float fadd_s(float a,float b){float r;asm("v_add_f32_e32 %0, %1, %2":"=v"(r):"v"(a),"v"(b));return r;}
__device__ __forceinline__ float fsub_s(float a,float b){float r;asm("v_sub_f32_e32 %0, %1, %2":"=v"(r):"v"(a),"v"(b));return r;}
typedef float f32x2_t __attribute__((ext_vector_type(2))); typedef __bf16 bf16x2_t __attribute__((ext_vector_type(2)));
__device__ __forceinline__ unsigned cvtpk_s(float lo,float hi){f32x2_t v={lo,hi};bf16x2_t b=__builtin_convertvector(v,bf16x2_t);return __builtin_bit_cast(unsigned,b);}
#define WAIT_BAR(N) asm volatile("s_waitcnt vmcnt(" #N ") lgkmcnt(0)\n\ts_barrier":::"memory")

__device__ __forceinline__ void qkt(f32x16&p0,f32x16&p1,const char*Kslot,const bf16x8*qr,const f32x16&negm,int r32,int hi){
  const char*kb=Kslot+hi*1024+r32*16;
  #pragma unroll
  for(int d0=0;d0<4;++d0){
    const bf16x8 b0=*reinterpret_cast<const bf16x8*>(kb+d0*2048);
    const bf16x8 b1=*reinterpret_cast<const bf16x8*>(kb+d0*2048+512);
    if(d0==0){p0=__builtin_amdgcn_mfma_f32_32x32x16_bf16(b0,qr[0],negm,0,0,0);p1=__builtin_amdgcn_mfma_f32_32x32x16_bf16(b1,qr[0],negm,0,0,0);}
    else{p0=__builtin_amdgcn_mfma_f32_32x32x16_bf16(b0,qr[d0],p0,0,0,0);p1=__builtin_amdgcn_mfma_f32_32x32x16_bf16(b1,qr[d0],p1,0,0,0);}}
}
typedef __attribute__((address_space(3))) const char* lds_cptr;
typedef short v4i16_t __attribute__((ext_vector_type(4)));
__device__ __forceinline__ void kload8(bf16x8*kf,lds_cptr kp){
  kf[0]=*(const __attribute__((address_space(3))) bf16x8*)(kp);      kf[1]=*(const __attribute__((address_space(3))) bf16x8*)(kp+512);
  kf[2]=*(const __attribute__((address_space(3))) bf16x8*)(kp+2048); kf[3]=*(const __attribute__((address_space(3))) bf16x8*)(kp+2560);
  kf[4]=*(const __attribute__((address_space(3))) bf16x8*)(kp+4096); kf[5]=*(const __attribute__((address_space(3))) bf16x8*)(kp+4608);
  kf[6]=*(const __attribute__((address_space(3))) bf16x8*)(kp+6144); kf[7]=*(const __attribute__((address_space(3))) bf16x8*)(kp+6656);
}
__device__ __forceinline__ void kload2(bf16x8*kf,lds_cptr kp,int j){ kf[2*j]=*(const __attribute__((address_space(3))) bf16x8*)(kp+j*2048); kf[2*j+1]=*(const __attribute__((address_space(3))) bf16x8*)(kp+j*2048+512); }
__device__ __forceinline__ s16x4 vtr(lds_cptr p){ return __builtin_bit_cast(s16x4,__builtin_amdgcn_ds_read_tr16_b64_v4i16((__attribute__((address_space(3))) v4i16_t*)p)); }
__device__ __forceinline__ float rowmax(const f32x16&p0,const f32x16&p1){
  float a=max3f(p0[0],p0[1],p1[0]),b=max3f(p0[2],p0[3],p1[1]);a=max3f(a,p1[2],p1[3]);
  #pragma unroll
  for(int r=4;r<16;r+=4){a=max3f(a,p0[r],p0[r+1]);b=max3f(b,p0[r+2],p0[r+3]);a=max3f(a,p1[r],p1[r+1]);b=max3f(b,p1[r+2],p1[r+3]);}
  const float m=max2f(a,b);
  auto rr=__builtin_amdgcn_permlane32_swap(__float_as_uint(m),__float_as_uint(m),false,false);
  return max2f(__uint_as_float(rr[0]),__uint_as_float(rr[1]));
}
__device__ __forceinline__ void pv(f32x16*o,int vb,bf16x8 pa0,bf16x8 pa1,bf16x8 pa2,bf16x8 pa3){
  #pragma unroll
  for(int d0=0;d0<2;++d0){s16x4 lo[4],hi[4];
    #pragma unroll
    for(int ks=0;ks<4;++ks){
      asm volatile("ds_read_b64_tr_b16 %0,%1 offset:%c2":"=&v"(lo[ks]):"v"(vb),"i"(d0*4096+ks*1024):"memory");
      asm volatile("ds_read_b64_tr_b16 %0,%1 offset:%c2":"=&v"(hi[ks]):"v"(vb),"i"(d0*4096+ks*1024+512):"memory");}
    asm volatile("s_waitcnt lgkmcnt(0)":::"memory");SBAR();
    #define PK(k) (bf16x8){lo[k][0],lo[k][1],lo[k][2],lo[k][3],hi[k][0],hi[k][1],hi[k][2],hi[k][3]}
    o[d0]=__builtin_amdgcn_mfma_f32_32x32x16_bf16(pa0,PK(0),o[d0],0,0,0);
    o[d0]=__builtin_amdgcn_mfma_f32_32x32x16_bf16(pa1,PK(1),o[d0],0,0,0);
    o[d0]=__builtin_amdgcn_mfma_f32_32x32x16_bf16(pa2,PK(2),o[d0],0,0,0);
    o[d0]=__builtin_amdgcn_mfma_f32_32x32x16_bf16(pa3,PK(3),o[d0],0,0,0);
    #undef PK
  }
}

#ifndef ATTN_STORE16
#define ATTN_STORE16(p,v) (*(u32x4*)(p)=(v))
#endif
template<int THRL> __device__ __forceinline__ void attn_unit(int b,int h,int qb,const bf16*Q,const bf16*__restrict__ K,const bf16*__restrict__ V,bf16*O,const float*__restrict__ KMG,char*shm,const bool load_km){
  int tid_=threadIdx.x; asm volatile("":"+v"(tid_)); const int tid=tid_,lane=tid&63,r32=lane&31,hi=lane>>5; const int wid=__builtin_amdgcn_readfirstlane(tid>>6);
  const long rowbase=(long)b*SEQ; const int q0=qb*QB;
  const bf16*Qw=Q+(rowbase+q0+wid*QBLK)*DM+h*D;
  const bf16*Kh=K+rowbase*DM+h*D,*Vh=V+rowbase*DM+h*D;
  const unsigned lds0=(unsigned)(uintptr_t)shm;
  float*wsf=(float*)(shm+LDS_WS)+wid*64;
  const bf16*ksrc=Kh+(long)lane*DM+wid*8;
  const bf16*vsrc=Vh+(long)(16*(wid&3)+(lane>>2))*DM+(wid>>2)*32+(lane&3)*8;
  const unsigned kdst=lds0+LDS_K+wid*1024, vdst=lds0+LDS_V+wid*1024;
  #define TILE(p) (((p)<4)?(NT-4+(p)):((p)-4))
  #define DMA_K(t,slot) glds16(ksrc+(long)TILE(t)*KVBLK*DM,(unsigned)__builtin_amdgcn_readfirstlane(kdst+(slot)))
  #define DMA_V(t,slot) glds16(vsrc+(long)TILE(t)*KVBLK*DM,(unsigned)__builtin_amdgcn_readfirstlane(vdst+(slot)))
  const int vb0=(int)(lds0+LDS_V)+((lane>>4)&1)*32+(lane&3)*8+(4*hi+((lane&15)>>2))*64;
  const char*Kbase=shm+LDS_K; bf16x8 kf[8];
  const lds_cptr shm3=(lds_cptr)shm; const lds_cptr kp0=shm3+LDS_K+hi*1024+r32*16; const lds_cptr vp0=shm3+LDS_V+((lane>>4)&1)*32+(lane&3)*8+(4*hi+((lane&15)>>2))*64;
  const int NT=(q0+QB)/KVBLK;
  if(load_km){ float*kml=(float*)(shm+LDS_KM); const int idx=tid*4; const int blk=idx>>6,dd=idx&63; const float*kp=KMG+((long)(b*32+blk)*16*DM+h*D+dd);
    float4 s4=*(const float4*)kp;
    #pragma unroll
    for(int p=1;p<16;++p){const float4 v4=*(const float4*)(kp+(long)p*DM); s4.x+=v4.x;s4.y+=v4.y;s4.z+=v4.z;s4.w+=v4.w;}
    s4.x*=(1.f/256.f);s4.y*=(1.f/256.f);s4.z*=(1.f/256.f);s4.w*=(1.f/256.f);
    *(float4*)(kml+idx)=s4; }
  DMA_K(0,0);DMA_V(0,0);DMA_K(1,SLOTB);
  bf16x8 qr[4];
  #pragma unroll
  for(int d0=0;d0<4;++d0)qr[d0]=*reinterpret_cast<const bf16x8*>(&Qw[(long)r32*DM+d0*16+hi*8]);
  __syncthreads();
  unsigned selm=0u;
  if(qb>0){
    float qf[32];
    #pragma unroll
    for(int d0=0;d0<4;++d0){
      #pragma unroll
      for(int e=0;e<8;++e)qf[d0*8+e]=__uint_as_float(((unsigned)(unsigned short)qr[d0][e])<<16);}
    float b0=-INFINITY,b1=-INFINITY,b2=-INFINITY; int i0=-1,i1=-1,i2=-1;
    const float*kml=(const float*)(shm+LDS_KM)+hi*8;
    for(int j=0;j<qb;++j){
      float g=0.f;
      #pragma unroll
      for(int d0=0;d0<4;++d0){
        const float4 ka=*(const float4*)(kml+j*64+d0*16),kb4=*(const float4*)(kml+j*64+d0*16+4);
        g+=qf[d0*8+0]*ka.x+qf[d0*8+1]*ka.y+qf[d0*8+2]*ka.z+qf[d0*8+3]*ka.w+qf[d0*8+4]*kb4.x+qf[d0*8+5]*kb4.y+qf[d0*8+6]*kb4.z+qf[d0*8+7]*kb4.w;}
      g+=__shfl_xor(g,32);
      if(g>b0){b2=b1;i2=i1;b1=b0;i1=i0;b0=g;i0=j;}
      else if(g>b1){b2=b1;i2=i1;b1=g;i1=j;}
      else if(g>b2){b2=g;i2=j;}
    }
    if(i0>=0)selm|=1u<<i0; if(i1>=0)selm|=1u<<i1; if(i2>=0)selm|=1u<<i2;
  }
  float mhat=0.f,l_reg=0.f;f32x16 o[2];o[0]=f32x16{};o[1]=f32x16{};const f32x16 zero16=f32x16{};
  const int qrel=wid*QBLK+r32;
  #define CMASK_ROW(P0,P1,t) do{ const float pen_=((selm>>((((t)-4)>>2)&31))&1u)?-mhat:-INFINITY; P0=P0+pen_; P1=P1+pen_; }while(0)
  #define CMASK_FULL(P0,P1,t) do{ if((t)<4){ const float nm_=-mhat; P0=P0+nm_; P1=P1+nm_; cmask(P0,P1,(t),qrel,hi);} else CMASK_ROW(P0,P1,t); }while(0)
  #define CMASK(P0,P1,t) CMASK_FULL(P0,P1,t)
  bool resc=false;
  #define START(P0,P1) do{ const float rm=rowmax(P0,P1); resc=false; \
    { const float dl=rm; mhat=fadd_s(mhat,dl); \
      _Pragma("unroll") for(int r=0;r<16;++r){P0[r]=fsub_s(P0[r],dl);P1[r]=fsub_s(P1[r],dl);} \
      } \
    _Pragma("unroll") for(int r=0;r<16;++r)P0[r]=__builtin_amdgcn_exp2f(P0[r]); }while(0)
  #define RESC() do{ if(resc){ asm volatile("s_waitcnt lgkmcnt(0)":::"memory"); \
      _Pragma("unroll") for(int d_=0;d_<2;++d_) _Pragma("unroll") for(int r=0;r<16;++r)o[d_][r]*=wsf[crow(r,hi)]; } }while(0)
  f32x16 pA0,pA1,pB0,pB1;
  int sl_prev=0,sl_cur=0,sl_next=SLOTB;
  #define ROT() do{sl_prev=sl_cur;sl_cur=sl_next;sl_next=(sl_next==(NSLOT-1)*SLOTB)?0:sl_next+SLOTB;}while(0)
  DMA_K(2,2*SLOTB);
  WAIT_BAR(3);
  qkt(pA0,pA1,Kbase,qr,zero16,r32,hi);asm volatile("s_nop 15\n\ts_nop 7":"+v"(pA0),"+v"(pA1));cmask(pA0,pA1,0,qrel,hi);
  START(pA0,pA1);
  _Pragma("unroll") for(int r=0;r<16;++r)pA1[r]=__builtin_amdgcn_exp2f(pA1[r]);
  WAIT_BAR(0);
  DMA_K(3,0);DMA_V(1,SLOTB);
  ROT();
  kload8(kf,kp0+sl_cur);
  WAIT_BAR(2);
  s16x4 vlo[8],vhi[8]; u32x4 pw0,pw1,pw2,pw3;
  #define PKW(P,B) cvtpk_s(P[B],P[B+1])
  #define PAF(k) __builtin_bit_cast(bf16x8,pw##k)
  #define VFR(i) (bf16x8){vlo[i][0],vlo[i][1],vlo[i][2],vlo[i][3],vhi[i][0],vhi[i][1],vhi[i][2],vhi[i][3]}
  #define PIN(x) asm volatile("":"+v"(x))
  #define MX3(a,b,c) __builtin_fmaxf(__builtin_fmaxf((a),(b)),(c))
  #define GAPA(MF,A0,A1,A2,A3,W0,W1,PW) do{ MF; sacc+=A0; sacc+=A1; sacc+=A2; sacc+=A3; PIN(sacc); W0; W1; PIN(PW); SBAR(); }while(0)
  #define EX(v) __builtin_amdgcn_exp2f(v)
  #define GAPB(MF,X,B) do{ MF; X[B]=EX(X[B]); X[B+1]=EX(X[B+1]); X[B+2]=EX(X[B+2]); X[B+3]=EX(X[B+3]); PIN(X); SBAR(); }while(0)
  #define VRD(i) do{ vlo[i]=vtr(vp_+(((i)>>2)*4096+((i)&3)*1024)); vhi[i]=vtr(vp_+(((i)>>2)*4096+((i)&3)*1024+512)); }while(0)
  #define KRD(G,j) do{ if(G){ kload2(kf,kp0+sl_next,j); SBAR(); } }while(0)
  #define STEP(C0,C1,P0,P1,t,GK,GV,GL) do{ SBAR(); \
    const lds_cptr vp_=vp0+sl_prev; \
    VRD(0); SBAR(); float sacc=(P0[0]+P0[1]); \
    GAPA(C0=__builtin_amdgcn_mfma_f32_32x32x16_bf16(kf[0],qr[0],zero16,0,0,0), P0[2],P0[3],P0[4],P0[5],     pw0[0]=PKW(P0,0), pw0[1]=PKW(P0,2), pw0); \
    VRD(4); SBAR(); GAPA(C1=__builtin_amdgcn_mfma_f32_32x32x16_bf16(kf[1],qr[0],zero16,0,0,0), P0[6],P0[7],P0[8],P0[9],     pw0[2]=PKW(P0,4), pw0[3]=PKW(P0,6), pw0); \
    VRD(1); SBAR(); GAPA(C0=__builtin_amdgcn_mfma_f32_32x32x16_bf16(kf[2],qr[1],C0,0,0,0),   P0[10],P0[11],P0[12],P0[13], pw1[0]=PKW(P0,8), pw1[1]=PKW(P0,10), pw1); \
    VRD(5); SBAR(); GAPA(C1=__builtin_amdgcn_mfma_f32_32x32x16_bf16(kf[3],qr[1],C1,0,0,0),   P0[14],P0[15],P1[0],P1[1],   pw1[2]=PKW(P0,12),pw1[3]=PKW(P0,14), pw1); \
    VRD(2); SBAR(); GAPA(C0=__builtin_amdgcn_mfma_f32_32x32x16_bf16(kf[4],qr[2],C0,0,0,0),   P1[2],P1[3],P1[4],P1[5],     pw2[0]=PKW(P1,0), pw2[1]=PKW(P1,2), pw2); \
    VRD(6); SBAR(); GAPA(C1=__builtin_amdgcn_mfma_f32_32x32x16_bf16(kf[5],qr[2],C1,0,0,0),   P1[6],P1[7],P1[8],P1[9],     pw2[2]=PKW(P1,4), pw2[3]=PKW(P1,6), pw2); \
    VRD(3); SBAR(); GAPA(C0=__builtin_amdgcn_mfma_f32_32x32x16_bf16(kf[6],qr[3],C0,0,0,0),   P1[10],P1[11],P1[12],P1[13], pw3[0]=PKW(P1,8), pw3[1]=PKW(P1,10), pw3); \
    VRD(7); SBAR(); GAPA(C1=__builtin_amdgcn_mfma_f32_32x32x16_bf16(kf[7],qr[3],C1,0,0,0),   P1[14],P1[15],0.f,0.f,       pw3[2]=PKW(P1,12),pw3[3]=PKW(P1,14), pw3); \
    l_reg+=sacc; \
    if(GK){DMA_K((t)+3,sl_cur);} if(GV){DMA_V((t)+1,sl_next);} \
    CMASK(C0,C1,t); \
    { float a=MX3(C0[0],C0[1],C1[0]),b=MX3(C0[2],C0[3],C1[1]); a=MX3(a,C1[2],C1[3]); \
      _Pragma("unroll") for(int r=4;r<16;r+=4){a=MX3(a,C0[r],C0[r+1]);b=MX3(b,C0[r+2],C0[r+3]);a=MX3(a,C1[r],C1[r+1]);b=MX3(b,C1[r+2],C1[r+3]);} \
      float rm=__builtin_fmaxf(a,b); { auto rr=__builtin_amdgcn_permlane32_swap(__float_as_uint(rm),__float_as_uint(rm),false,false); rm=__builtin_fmaxf(__uint_as_float(rr[0]),__uint_as_float(rr[1])); } \
      resc=false; \
      if(__builtin_expect(__any(rm>(float)THRL),0)){ const float dl=__builtin_fmaxf(rm,0.f); mhat+=dl; \
        _Pragma("unroll") for(int r=0;r<16;++r){C0[r]-=dl;C1[r]-=dl;} \
        const float f=__builtin_amdgcn_exp2f(-dl); l_reg*=f; if(hi==0)wsf[r32]=f; resc=true; } } \
    SBAR(); \
    GAPB(o[0]=__builtin_amdgcn_mfma_f32_32x32x16_bf16(PAF(0),VFR(0),o[0],0,0,0), C0,0); \
    GAPB(o[1]=__builtin_amdgcn_mfma_f32_32x32x16_bf16(PAF(0),VFR(4),o[1],0,0,0), C0,4); \
    KRD(GL,0); GAPB(o[0]=__builtin_amdgcn_mfma_f32_32x32x16_bf16(PAF(1),VFR(1),o[0],0,0,0), C0,8); \
    KRD(GL,1); GAPB(o[1]=__builtin_amdgcn_mfma_f32_32x32x16_bf16(PAF(1),VFR(5),o[1],0,0,0), C0,12); \
    KRD(GL,2); GAPB(o[0]=__builtin_amdgcn_mfma_f32_32x32x16_bf16(PAF(2),VFR(2),o[0],0,0,0), C1,0); \
    KRD(GL,3); GAPB(o[1]=__builtin_amdgcn_mfma_f32_32x32x16_bf16(PAF(2),VFR(6),o[1],0,0,0), C1,4); \
    GAPB(o[0]=__builtin_amdgcn_mfma_f32_32x32x16_bf16(PAF(3),VFR(3),o[0],0,0,0), C1,8); \
    GAPB(o[1]=__builtin_amdgcn_mfma_f32_32x32x16_bf16(PAF(3),VFR(7),o[1],0,0,0), C1,12); \
    }while(0)
  int t=1;
  #define ENDW(tt) do{ if((tt)+3<NT){WAIT_BAR(2);} else if((tt)+2<NT){WAIT_BAR(1);} else {WAIT_BAR(0);} }while(0)
  for(;t<5&&t+1<NT;t+=2){
    STEP(pB0,pB1,pA0,pA1,t,(t+3<NT),(t+1<NT),(t+1<NT));       ENDW(t);   RESC(); ROT();
    STEP(pA0,pA1,pB0,pB1,t+1,(t+4<NT),(t+2<NT),(t+2<NT));     ENDW(t+1); RESC(); ROT();
  }
  #undef CMASK
  #define CMASK(P0,P1,t) CMASK_ROW(P0,P1,t)
  for(;t+5<NT;t+=2){
    STEP(pB0,pB1,pA0,pA1,t,true,true,true);     WAIT_BAR(2); RESC(); ROT();
    STEP(pA0,pA1,pB0,pB1,t+1,true,true,true);   WAIT_BAR(2); RESC(); ROT();
  }
  for(;t+1<NT;t+=2){
    STEP(pB0,pB1,pA0,pA1,t,(t+3<NT),(t+1<NT),(t+1<NT));       ENDW(t);   RESC(); ROT();
    STEP(pA0,pA1,pB0,pB1,t+1,(t+4<NT),(t+2<NT),(t+2<NT));     ENDW(t+1); RESC(); ROT();
  }
  #undef CMASK
  #define CMASK(P0,P1,t) CMASK_FULL(P0,P1,t)
  STEP(pB0,pB1,pA0,pA1,NT-1,false,false,false); RESC();
  { float sacc=pB0[0]+pB0[1]; _Pragma("unroll") for(int r=2;r<16;++r)sacc+=pB0[r]; _Pragma("unroll") for(int r=0;r<16;++r)sacc+=pB1[r]; l_reg+=sacc;
    pw0=(u32x4){PKW(pB0,0),PKW(pB0,2),PKW(pB0,4),PKW(pB0,6)};pw1=(u32x4){PKW(pB0,8),PKW(pB0,10),PKW(pB0,12),PKW(pB0,14)};pw2=(u32x4){PKW(pB1,0),PKW(pB1,2),PKW(pB1,4),PKW(pB1,6)};pw3=(u32x4){PKW(pB1,8),PKW(pB1,10),PKW(pB1,12),PKW(pB1,14)};
    SBAR(); pv(o,vb0+sl_cur,PAF(0),PAF(1),PAF(2),PAF(3)); }
  #undef PKW
  #undef PAF
  #undef VFR
  #undef PIN
  #undef MX3
  #undef GAPA
  #undef GAPB
  #undef EX
  #undef VRD
  #undef KRD
  #undef STEP
  #undef ENDW
  {auto rr=__builtin_amdgcn_permlane32_swap(__float_as_uint(l_reg),__float_as_uint(l_reg),false,false);l_reg=__uint_as_float(rr[0])+__uint_as_float(rr[1]);}
  if(hi==0)wsf[32+r32]=l_reg;asm volatile("s_waitcnt lgkmcnt(0)":::"memory");
  float rli[16];
  #pragma unroll
  for(int r=0;r<16;++r)rli[r]=__builtin_amdgcn_rcpf(wsf[32+crow(r,hi)]);
  bf16*Ow=O+(rowbase+q0+wid*QBLK)*DM+h*D;
  { bf16*stg=(bf16*)(shm+LDS_OST)+wid*2048;
    #pragma unroll
    for(int r=0;r<16;++r){const int orow=crow(r,hi);
      #pragma unroll
      for(int d0=0;d0<2;++d0)stg[orow*64+d0*32+r32]=__float2bfloat16(o[d0][r]*rli[r]);}
    asm volatile("s_waitcnt lgkmcnt(0)":::"memory");
    #pragma unroll
    for(int i=0;i<4;++i){const int row=i*8+(lane>>3),ch=lane&7; const u32x4 v=*(const u32x4*)(stg+row*64+ch*8); ATTN_STORE16(Ow+(long)row*DM+ch*8,v);} }
  asm volatile("s_waitcnt lgkmcnt(0)\n\ts_barrier":::"memory");
  #undef DMA_K
  #undef TILE
  #undef DMA_V
  #undef CMASK
  #undef CMASK_ROW
  #undef CMASK_FULL
  #undef START
  #undef RESC
  #undef ROT
}
constexpr int ATTN_LDS_BYTES=LDS_BYTES;
struct AttnTensors { const bf16* Q; const bf16* K; const bf16* V; bf16* O; const float* KM; };
struct AttnUnit { int bh; int qb; };
struct StaticOrder {
  int vcu,G;
  __device__ __forceinline__ explicit StaticOrder(int grid,int block):vcu((grid%8==0)?(block%8)*(grid/8)+block/8:block),G(grid){}
  __device__ __forceinline__ bool next(int i,AttnUnit&u)const{ const int pr=(i>>1)*G+vcu; if(pr>=256)return false; const int s=pr&15; u.bh=pr>>4; u.qb=(i&1)?31-s:s; return true; }
};
template<class Sched,int THRL=8> __device__ __forceinline__ void attn_phase(char*lds,const AttnTensors&T,const Sched&S){
  AttnUnit u;
  int last_bh=-1;
  for(int i=0;S.next(i,u);++i){ attn_unit<THRL>(u.bh/NHEAD,u.bh%NHEAD,u.qb,T.Q,T.K,T.V,T.O,T.KM,lds,u.bh!=last_bh); last_bh=u.bh; }
}
#undef SBAR
#undef WAIT_BAR
}
namespace xb {
#define GAS __attribute__((address_space(1)))
#define LAS __attribute__((address_space(3)))
typedef GAS unsigned gu32;
typedef GAS unsigned long long gu64;
#define RLX_AGENT __ATOMIC_RELAXED, __HIP_MEMORY_SCOPE_AGENT
#define LDS_WAIT() asm volatile("s_waitcnt lgkmcnt(0)" ::: "memory")
#define VM_WAIT() asm volatile("s_waitcnt vmcnt(0)" ::: "memory")
__device__ __forceinline__ unsigned long long rt() { return __builtin_amdgcn_s_memrealtime(); }
#define XB_TMO      128
#define XB_XCNT(j)  (256  + 64 * (j))
#define XB_XSUB(j)  (1280 + 64 * (j))
#define XB_XGEN(j)  (2304 + 64 * (j))
#define XB_TOP      3328
#define XB_TOPGEN   3392
#define XCD_BAR_WORDS 3456
#define XB_SPIN_CAP (1u << 18)

__device__ __forceinline__ unsigned xb_ld(unsigned* p)              { return __hip_atomic_load(p, __ATOMIC_RELAXED, __HIP_MEMORY_SCOPE_AGENT); }
__device__ __forceinline__ unsigned xb_add(unsigned* p, unsigned v) { return __hip_atomic_fetch_add(p, v, __ATOMIC_RELAXED, __HIP_MEMORY_SCOPE_AGENT); }
__device__ __forceinline__ unsigned xb_xcc_id() { return (unsigned)__builtin_amdgcn_s_getreg((3 << 11) | 20) & 0xFu; }
#define XB_SPIN(cond, bar) do { unsigned _sp = 0; while (cond) { __builtin_amdgcn_s_sleep(1); \
    if ((++_sp & 255u) == 0u) { if (xb_ld(&(bar)[XB_TMO])) break; if (_sp > XB_SPIN_CAP) { atomicAdd(&(bar)[XB_TMO], 1u); break; } } } } while (0)

struct XcdBarrier {
    unsigned* bar; unsigned x;
    volatile LAS unsigned* st;
};

__device__ __forceinline__ XcdBarrier xcd_barrier_post(unsigned* bar, volatile LAS unsigned* st) {
    XcdBarrier b; b.bar = bar; b.x = xb_xcc_id(); b.st = st;
    if (threadIdx.x == 0) (void)xb_add(&bar[XB_XCNT(b.x)], 1u);
    return b;
}
__device__ __forceinline__ void xcd_barrier_complete(unsigned* bar, unsigned x, unsigned& nloc, unsigned& nx) {
    const unsigned G = gridDim.x * gridDim.y * gridDim.z;
    unsigned sum, cnt, mine, sp = 0u;
    for (;;) {
        sum = 0u; cnt = 0u; mine = 0u;
#pragma unroll
        for (unsigned j = 0; j < 16; ++j) { const unsigned c = xb_ld(&bar[XB_XCNT(j)]); sum += c; cnt += (c > 0u) ? 1u : 0u; mine = (j == x) ? c : mine; }
        if (sum == G) break;
        __builtin_amdgcn_s_sleep(1);
        if ((++sp & 255u) == 0u) { if (xb_ld(&bar[XB_TMO])) break; if (sp > XB_SPIN_CAP) { atomicAdd(&bar[XB_TMO], 1u); break; } }
    }
    nloc = mine > 0u ? mine : 1u; nx = cnt > 0u ? cnt : 1u;
}

__device__ __forceinline__ void xcd_barrier(const XcdBarrier& b) {
    asm volatile("s_waitcnt vmcnt(0)" ::: "memory");
    __syncthreads();
    if (threadIdx.x == 0) {
        unsigned* bar = b.bar;
        __builtin_amdgcn_s_waitcnt(0);
        unsigned nloc = b.st[0], nx = b.st[1];
        if (nloc == 0u) { xcd_barrier_complete(bar, b.x, nloc, nx); b.st[0] = nloc; b.st[1] = nx; }
        const unsigned old = xb_add(&bar[XB_XSUB(b.x)], 1u);
        const unsigned gen = old / nloc;
        if (old + 1u == (gen + 1u) * nloc) {
            __builtin_amdgcn_fence(__ATOMIC_RELEASE, "agent");
            asm volatile("s_waitcnt vmcnt(0)" ::: "memory");
            const unsigned og = xb_add(&bar[XB_TOP], 1u);
            const unsigned tg = og / nx;
            if (og + 1u == (tg + 1u) * nx) xb_add(&bar[XB_TOPGEN], 1u);
            else XB_SPIN(xb_ld(&bar[XB_TOPGEN]) == tg, bar);
            __builtin_amdgcn_fence(__ATOMIC_ACQUIRE, "agent");
            xb_add(&bar[XB_XGEN(b.x)], 1u);
            asm volatile("s_waitcnt vmcnt(0)" ::: "memory");
        } else {
            XB_SPIN(xb_ld(&bar[XB_XGEN(b.x)]) == gen, bar);
            __builtin_amdgcn_fence(__ATOMIC_ACQUIRE, "agent");
            asm volatile("s_waitcnt vmcnt(0)" ::: "memory");
        }
    }
    __syncthreads();
}

#define XB_LSUB(j)  (3456 + 64 * (j))
#define XB_LGEN(j)  (4480 + 64 * (j))
#define XB_CLS(j)   (5504 + 64 * (j))
#define XB_MISMATCH 6528
__device__ __forceinline__ void xcd_local_post(const XcdBarrier& b) {
    if (threadIdx.x == 0) { const unsigned cls = 1u + (blockIdx.x & 7u); unsigned expect = 0u;
        if (!__hip_atomic_compare_exchange_strong(&b.bar[XB_CLS(b.x)], &expect, cls, __ATOMIC_RELAXED, __ATOMIC_RELAXED, __HIP_MEMORY_SCOPE_AGENT) && expect != cls) xb_add(&b.bar[XB_MISMATCH], 1u); }
}
__device__ __forceinline__ bool xcd_local_ok(const XcdBarrier& b) {
    const unsigned nloc = b.st[0], nx = b.st[1];
    return xb_ld(&b.bar[XB_MISMATCH]) == 0u && nx == 8u && nloc * 8u == gridDim.x;
}
__device__ __forceinline__ void xcd_barrier_local(const XcdBarrier& b) {
    asm volatile("s_waitcnt vmcnt(0)" ::: "memory");
    __syncthreads();
    if (threadIdx.x == 0) {
        unsigned* bar = b.bar; const unsigned nloc = b.st[0];
        const unsigned old = xb_add(&bar[XB_LSUB(b.x)], 1u), gen = old / nloc;
        if (old + 1u == (gen + 1u) * nloc) xb_add(&bar[XB_LGEN(b.x)], 1u);
        else XB_SPIN(xb_ld(&bar[XB_LGEN(b.x)]) == gen, bar);
        __builtin_amdgcn_fence(__ATOMIC_ACQUIRE, "agent");
        asm volatile("s_waitcnt vmcnt(0)" ::: "memory");
    }
    __syncthreads();
}
}
#ifndef REP_CONV
#define REP_CONV 1
#endif
#ifndef REP_SGU
#define REP_SGU 1
#endif
namespace mk {
typedef unsigned short bf16;
typedef float f32x4 __attribute__((ext_vector_type(4)));
typedef float f32x2 __attribute__((ext_vector_type(2)));
typedef unsigned u32x4 __attribute__((ext_vector_type(4)));
typedef unsigned u32x2 __attribute__((ext_vector_type(2)));
typedef short bf16x8 __attribute__((ext_vector_type(8)));
typedef __bf16 bf16x2_t __attribute__((ext_vector_type(2)));

constexpr int NWV = 8, NTHR = 512;
constexpr int SEQ = 8192, TOK = 2 * SEQ, DM = 1024, FF = 2816, NIN = 6656, CW = 512, NLAYER = 2;
constexpr float EPS = 1e-6f;
constexpr float C2 = 0.125f * 1.4426950408889634f;
constexpr size_t MiB = 1u << 20;
constexpr size_t WS_ROPE = 1 * MiB, WS_KMEAN = 2 * MiB, WS_SS = MiB + MiB / 2;
constexpr size_t WS_WFI = 4 * MiB, WS_WFO = 15 * MiB, WS_WIN = 21 * MiB, WS_WBR = 34 * MiB, WS_WOUT = 37 * MiB;
constexpr size_t WS_XN = 40 * MiB;
constexpr size_t WS_K = 72 * MiB, WS_V = 88 * MiB, WS_MERGED = 72 * MiB;
constexpr size_t WS_ACT = 104 * MiB;
constexpr size_t ARENA = 11 * MiB, WS_GLU = WS_ACT, WS_U = WS_ACT + 2 * MiB;
__host__ __device__ __forceinline__ size_t arena_off(int row) { return (size_t)(row >> 11) * (ARENA / 2) + (size_t)(row & 2047) * 512; }
constexpr size_t WS_GATES = 192 * MiB;
constexpr size_t WS_FALT_WI = 240 * MiB, WS_FALT_WO = 251 * MiB, WS_END = 256 * MiB + MiB / 2;
constexpr int LDS_RS = 131072 + 256, LDS_GB = LDS_RS + 8 * 256 * 4, LDS_BYTES = LDS_GB + 8 * 256 * 4;

__device__ __forceinline__ float bf2f(unsigned h) { return __uint_as_float(h << 16); }
__device__ __forceinline__ float bflo(unsigned u) { return __uint_as_float(u << 16); }
__device__ __forceinline__ float bfhi(unsigned u) { return __uint_as_float(u & 0xffff0000u); }
__device__ __forceinline__ unsigned pk2(float lo, float hi) { f32x2 v = {lo, hi}; bf16x2_t b = __builtin_convertvector(v, bf16x2_t); return __builtin_bit_cast(unsigned, b); }
__device__ __forceinline__ float sigm(float a) { return __builtin_amdgcn_rcpf(1.f + __builtin_amdgcn_exp2f(-1.4426950408889634f * a)); }
__device__ __forceinline__ f32x4 exp2v(f32x4 t) { return (f32x4){__builtin_amdgcn_exp2f(t[0]), __builtin_amdgcn_exp2f(t[1]), __builtin_amdgcn_exp2f(t[2]), __builtin_amdgcn_exp2f(t[3])}; }
__device__ __forceinline__ f32x4 rcpv(f32x4 t) { return (f32x4){__builtin_amdgcn_rcpf(t[0]), __builtin_amdgcn_rcpf(t[1]), __builtin_amdgcn_rcpf(t[2]), __builtin_amdgcn_rcpf(t[3])}; }
__device__ __forceinline__ f32x4 sigmv_neg(f32x4 tneg) { return rcpv(exp2v(tneg) + 1.0f); }
__device__ __forceinline__ float gelu_tanh(float x) { return x * sigm(1.5957691216057308f * (x + 0.044715f * x * x * x)); }
#define MK_DPP_ADD(v, ctrl) ((v) + __builtin_bit_cast(float, __builtin_amdgcn_update_dpp(0, __builtin_bit_cast(int, (v)), (ctrl), 0xF, 0xF, true)))
__device__ __forceinline__ float wave_sum(float v) {
    v = MK_DPP_ADD(v, 0xB1);
    v = MK_DPP_ADD(v, 0x4E);
    v = MK_DPP_ADD(v, 0x141);
    v = MK_DPP_ADD(v, 0x140);
    { auto r = __builtin_amdgcn_permlane16_swap(__float_as_uint(v), __float_as_uint(v), false, false); v = __uint_as_float(r[0]) + __uint_as_float(r[1]); }
    { auto r = __builtin_amdgcn_permlane32_swap(__float_as_uint(v), __float_as_uint(v), false, false); v = __uint_as_float(r[0]) + __uint_as_float(r[1]); }
    return v;
}
__device__ __forceinline__ void store8(bf16* p, f32x4 a, f32x4 b) { u32x4 w; w.x = pk2(a[0], a[1]); w.y = pk2(a[2], a[3]); w.z = pk2(b[0], b[1]); w.w = pk2(b[2], b[3]); *(u32x4*)p = w; }
__device__ __forceinline__ unsigned q8(float v) { return (unsigned)(v * 255.f + 0.5f); }
__device__ __forceinline__ void store8_u8(unsigned char* p, f32x4 a, f32x4 b) { u32x2 w; w.x = q8(a[0]) | (q8(a[1]) << 8) | (q8(a[2]) << 16) | (q8(a[3]) << 24); w.y = q8(b[0]) | (q8(b[1]) << 8) | (q8(b[2]) << 16) | (q8(b[3]) << 24); *(u32x2*)p = w; }
__device__ __forceinline__ void unpack8_u8(u32x2 w, f32x4& a, f32x4& b) { const float k = 1.f / 255.f;
    a = (f32x4){(float)(w.x & 255u) * k, (float)((w.x >> 8) & 255u) * k, (float)((w.x >> 16) & 255u) * k, (float)(w.x >> 24) * k};
    b = (f32x4){(float)(w.y & 255u) * k, (float)((w.y >> 8) & 255u) * k, (float)((w.y >> 16) & 255u) * k, (float)(w.y >> 24) * k}; }
__device__ __forceinline__ void unpack8(u32x4 w, f32x4& a, f32x4& b) { a = (f32x4){bflo(w.x), bfhi(w.x), bflo(w.y), bfhi(w.y)}; b = (f32x4){bflo(w.z), bfhi(w.z), bflo(w.w), bfhi(w.w)}; }

__device__ __forceinline__ float row_rs(const float* ss, int row) { const f32x4 p = *(const f32x4*)(ss + (size_t)row * 4); return 1.0f / sqrtf(((p.x + p.y) + (p.z + p.w)) * (1.f / DM) + EPS); }
struct EpiSwiGLU {
#ifdef DUP_EPI
    static constexpr bool DUP = true;
#endif
    static constexpr bool PERM = true, AFTER_DRAIN = false, KEEP_ACC = false;
    unsigned char* ws; const PG8_LAS float* rsl; mutable int ui;
    __device__ __forceinline__ void operator()(const f32x4 (&acc)[2][2][4][2], const pg8::Unit& u, int wr, int wc, int fr, int fq) const {
        bf16* O = (bf16*)(ws + WS_ACT); constexpr int ldc = FF; const PG8_LAS float* rl = rsl + ui * 256 + wr * 64 + fr; ++ui;
        const int row0 = u.pm * 256 + wr * 64 + fr, col = u.pn * 128 + wc * 32 + 8 * fq;
        float rsv[2][4];
#pragma unroll
        for (int ai = 0; ai < 2; ++ai)
#pragma unroll
            for (int m = 0; m < 4; ++m) rsv[ai][m] = rl[ai * 128 + m * 16];
#pragma unroll
        for (int ai = 0; ai < 2; ++ai)
#pragma unroll
            for (int m = 0; m < 4; ++m) {
                const int row = row0 + ai * 128 + m * 16; const float rs = rsv[ai][m];
                const float kneg = -1.4426950408889634f * rs, rs2 = rs * rs;
                const f32x4 o0 = (acc[ai][0][m][0] * acc[ai][1][m][0]) * (sigmv_neg(acc[ai][0][m][0] * kneg) * rs2);
                const f32x4 o1 = (acc[ai][0][m][1] * acc[ai][1][m][1]) * (sigmv_neg(acc[ai][0][m][1] * kneg) * rs2);
                store8(O + (size_t)row * ldc + col, o0, o1);
            }
    }
};
struct EpiResid {
    static constexpr bool PERM = true, AFTER_DRAIN = true, KEEP_ACC = false;
    float scale; unsigned char* ws;
    __device__ __forceinline__ void fused(f32x4 (&acc)[2][2][4][2], const pg8::Unit& u, int wr, int wc, int fr, int fq, PG8_LAS unsigned char* lds, int wid, int lane) const {
        bf16* XB = (bf16*)(ws + WS_XN); float* SS = (float*)(ws + WS_SS);
        const int col0 = u.pn * 256 + wc * 32 + 8 * fq;
        PG8_LAS float* Pl = (PG8_LAS float*)lds;
        u32x4 bv[2][4][2];
#pragma unroll
        for (int ai = 0; ai < 2; ++ai)
#pragma unroll
            for (int m = 0; m < 4; ++m)
#pragma unroll
                for (int bj = 0; bj < 2; ++bj) bv[ai][m][bj] = *(const u32x4*)(XB + (size_t)(u.pm * 256 + ai * 128 + wr * 64 + m * 16 + fr) * DM + col0 + bj * 128);
#pragma unroll
        for (int ai = 0; ai < 2; ++ai)
#pragma unroll
            for (int m = 0; m < 4; ++m) {
                const int rl = ai * 128 + wr * 64 + m * 16 + fr; float s = 0.f;
#pragma unroll
                for (int bj = 0; bj < 2; ++bj) {
                    const size_t off = (size_t)(u.pm * 256 + rl) * DM + col0 + bj * 128;
                    f32x4 b0, b1; unpack8(bv[ai][m][bj], b0, b1);
                    const f32x4 x0 = b0 + acc[ai][bj][m][0] * scale, x1 = b1 + acc[ai][bj][m][1] * scale;
                    store8(XB + off, x0, x1);
                    s += (x0.x * x0.x + x0.y * x0.y) + (x0.z * x0.z + x0.w * x0.w) + (x1.x * x1.x + x1.y * x1.y) + (x1.z * x1.z + x1.w * x1.w);
                }
                { auto r = __builtin_amdgcn_permlane16_swap(__float_as_uint(s), __float_as_uint(s), false, false); s = __uint_as_float(r[0]) + __uint_as_float(r[1]); }
                { auto r = __builtin_amdgcn_permlane32_swap(__float_as_uint(s), __float_as_uint(s), false, false); s = __uint_as_float(r[0]) + __uint_as_float(r[1]); }
                if (fq == 0) Pl[rl * 4 + wc] = s;
            }
        asm volatile("s_waitcnt lgkmcnt(0)" ::: "memory"); __builtin_amdgcn_s_barrier(); asm volatile("" ::: "memory");
        const int tid = wid * 64 + lane;
        if (tid < 256) { const PG8_LAS f32x4* P4 = (const PG8_LAS f32x4*)lds; const f32x4 p = P4[tid]; SS[(size_t)(u.pm * 256 + tid) * 4 + u.pn] = (p.x + p.y) + (p.z + p.w); }
    }
};
struct EpiWin {
#ifdef DUP_EPI
    static constexpr bool DUP = false;
#endif
    static constexpr bool PERM = true, AFTER_DRAIN = false, KEEP_ACC = false;
    unsigned char* ws; const float* gate_b; const PG8_LAS float* rsl; mutable int ui; unsigned char* ob;
    __device__ __forceinline__ void operator()(const f32x4 (&acc)[2][2][4][2], const pg8::Unit& u, int wr, int wc, int fr, int fq) const {
        const PG8_LAS float* rl = rsl + ui * 256 + wr * 64 + fr; ++ui;
        const size_t cls_ = (size_t)(u.pm >> 3) * (ARENA / 2) - (size_t)(u.pm >> 3) * 2048 * CW;
        bf16 *GLU = (bf16*)(ws + WS_GLU) + cls_, *U = (bf16*)(ws + WS_U) + cls_, *SV = (bf16*)(ob + 48 * MiB), *Q = (bf16*)(ob + 32 * MiB), *K = (bf16*)(ws + WS_K), *V = (bf16*)(ws + WS_V), *GATES_unused = nullptr; unsigned char* GATES = ws + WS_GATES; (void)GATES_unused;
        const float* rope = (const float*)(ws + WS_ROPE);
        const int pn = u.pn, row0 = u.pm * 256 + wr * 64 + fr, cw = wc * 32 + 8 * fq;
        float rsv[2][4];
#pragma unroll
        for (int ai = 0; ai < 2; ++ai)
#pragma unroll
            for (int m = 0; m < 4; ++m) rsv[ai][m] = rl[ai * 128 + m * 16];
        if (pn < 4) {
#pragma unroll
            for (int ai = 0; ai < 2; ++ai)
#pragma unroll
                for (int m = 0; m < 4; ++m) {
                    const float rs = rsv[ai][m], kneg = -1.4426950408889634f * rs;
                    const f32x4 o0 = acc[ai][0][m][0] * (sigmv_neg(acc[ai][1][m][0] * kneg) * rs), o1 = acc[ai][0][m][1] * (sigmv_neg(acc[ai][1][m][1] * kneg) * rs);
                    store8(GLU + (size_t)(row0 + ai * 128 + m * 16) * CW + pn * 128 + cw, o0, o1);
                }
        } else if (pn < 8) {
            bf16* dst = (pn < 6) ? U : SV; const int cb = (pn & 1) * 256 + cw;
#pragma unroll
            for (int ai = 0; ai < 2; ++ai)
#pragma unroll
                for (int m = 0; m < 4; ++m) { const float rs = rsv[ai][m];
#pragma unroll
                    for (int bj = 0; bj < 2; ++bj) {
                        const f32x4 x0 = acc[ai][bj][m][0] * rs, x1 = acc[ai][bj][m][1] * rs;
                        const f32x4 o0 = x0 * sigmv_neg((x0 * (x0 * x0 * 0.044715f + 1.0f)) * -2.3022082f), o1 = x1 * sigmv_neg((x1 * (x1 * x1 * 0.044715f + 1.0f)) * -2.3022082f);
                        store8(dst + (size_t)(row0 + ai * 128 + m * 16) * CW + cb + bj * 128, o0, o1);
                    } }
        } else if (pn < 12) {
            bf16* dst = (pn < 10) ? Q : K; const float sc = (pn < 10) ? C2 : 1.f; const int cb = (pn & 1) * 256 + cw;
            const bool ropew = (wc & 1) == 0;
#pragma unroll
            for (int bj = 0; bj < 2; ++bj) {
#pragma unroll
                for (int ai = 0; ai < 2; ++ai)
#pragma unroll
                    for (int m = 0; m < 4; ++m) {
                        const int row = row0 + ai * 128 + m * 16, pos = row & (SEQ - 1);
                        f32x4 v0 = acc[ai][bj][m][0], v1 = acc[ai][bj][m][1];
                        if (ropew) {
                            f32x4 c0 = {1.f, 1.f, 1.f, 1.f}, c1 = c0, s0 = {0.f, 0.f, 0.f, 0.f}, s1 = s0;
                            if (fq < 2) {
                                const float fp = (float)pos;
                                const float invf[8] = {1.0f, 0.1939227432012558f, 0.03760603070259094f, 0.007292664609849453f, 0.0014142135623842478f, 0.00027424818836152554f, 5.318296098266728e-05f, 1.0313386155758053e-05f};
#pragma unroll
                                for (int e = 0; e < 8; ++e) { const float a = fp * invf[e], p = a * 0.15915493667125702f, lo = __builtin_fmaf(a, 0.15915493667125702f, -p) + a * 6.4206382e-09f;
                                    const float r = __builtin_amdgcn_fractf(p) + lo; const float cv = __builtin_amdgcn_cosf(r), sv = __builtin_amdgcn_sinf(r);
                                    if (e < 4) { c0[e] = cv; s0[e] = sv; } else { c1[e - 4] = cv; s1[e - 4] = sv; } }
                            }
                            if (fq == 0) { s0 = -s0; s1 = -s1; }
                            f32x4 p0, p1;
#pragma unroll
                            for (int e = 0; e < 4; ++e) { p0[e] = __shfl_xor(v0[e], 16); p1[e] = __shfl_xor(v1[e], 16); }
                            v0 = v0 * c0 + p0 * s0; v1 = v1 * c1 + p1 * s1;
                        }
                        { const float scr = sc * rsv[ai][m]; store8(dst + (size_t)row * CW + cb + bj * 128, v0 * scr, v1 * scr); }
                    }
            }
        } else if (pn < 14) {
            const int cb = (pn & 1) * 256 + cw;
#pragma unroll
            for (int ai = 0; ai < 2; ++ai)
#pragma unroll
                for (int m = 0; m < 4; ++m)
#pragma unroll
                    for (int bj = 0; bj < 2; ++bj) { const float rs = rsv[ai][m]; store8(V + (size_t)(row0 + ai * 128 + m * 16) * CW + cb + bj * 128, acc[ai][bj][m][0] * rs, acc[ai][bj][m][1] * rs); }
        } else {
            const int gc = (pn - 14) * 256 + cw;
#pragma unroll
            for (int bj = 0; bj < 2; ++bj) {
                const PG8_LAS float* gbl = rsl + (LDS_GB - LDS_RS) / 4 + (ui - 1) * 256 + cw + bj * 128;
                const f32x4 bn0 = *(const PG8_LAS f32x4*)gbl * -1.4426950408889634f, bn1 = *(const PG8_LAS f32x4*)(gbl + 4) * -1.4426950408889634f;
#pragma unroll
                for (int ai = 0; ai < 2; ++ai)
#pragma unroll
                    for (int m = 0; m < 4; ++m) {
                        const float kneg = -1.4426950408889634f * rsv[ai][m];
                        const f32x4 o0 = sigmv_neg(acc[ai][bj][m][0] * kneg + bn0), o1 = sigmv_neg(acc[ai][bj][m][1] * kneg + bn1);
                        store8_u8(GATES + (size_t)(row0 + ai * 128 + m * 16) * 3072 + gc + bj * 128, o0, o1);
                    }
            }
        }
    }
};
struct EpiBranch {
#ifdef DUP_EPI
    static constexpr bool DUP = false;
#endif
    static constexpr bool PERM = true, AFTER_DRAIN = false, KEEP_ACC = true;
    const unsigned char* GATES; bf16* MERGED;
    __device__ __forceinline__ bool keep(const pg8::Unit& u) const { return (u.pm >> 6) < 2; }
    __device__ __forceinline__ void inplace(f32x4 (&acc)[2][2][4][2], const pg8::Unit& u, int wr, int wc, int fr, int fq) const {
        const int br = u.pm >> 6, row0 = (u.pm & 63) * 256 + wr * 64 + fr, col0 = (u.pn & 3) * 256 + wc * 32 + 8 * fq;
        u32x2 ga[2][4][2], gb[2][4][2];
#pragma unroll
        for (int ai = 0; ai < 2; ++ai)
#pragma unroll
            for (int m = 0; m < 4; ++m)
#pragma unroll
                for (int bj = 0; bj < 2; ++bj) {
                    const unsigned char* gp = GATES + (size_t)(row0 + ai * 128 + m * 16) * 3072 + br * 1024 + col0 + bj * 128;
                    ga[ai][m][bj] = *(const u32x2*)gp; gb[ai][m][bj] = (br < 2) ? *(const u32x2*)(gp + 1024) : (u32x2){0u, 0u};
                }
#pragma unroll
        for (int ai = 0; ai < 2; ++ai)
#pragma unroll
            for (int m = 0; m < 4; ++m)
#pragma unroll
                for (int bj = 0; bj < 2; ++bj) {
                    const int row = row0 + ai * 128 + m * 16, col = col0 + bj * 128;
                    f32x4 g0, g1; unpack8_u8(ga[ai][m][bj], g0, g1);
                    if (br > 0) {
#pragma unroll
                        for (int e = 0; e < 4; ++e) { g0[e] = __builtin_fmaxf(g0[e], 1e-6f); g1[e] = __builtin_fmaxf(g1[e], 1e-6f); } }
                    if (br < 2) {
                        f32x4 h0, h1; unpack8_u8(gb[ai][m][bj], h0, h1);
#pragma unroll
                        for (int e = 0; e < 4; ++e) { acc[ai][bj][m][0][e] *= g0[e] * __builtin_amdgcn_rcpf(__builtin_fmaxf(h0[e], 1e-6f)); acc[ai][bj][m][1][e] *= g1[e] * __builtin_amdgcn_rcpf(__builtin_fmaxf(h1[e], 1e-6f)); }
                    } else {
                        store8(MERGED + (size_t)row * DM + col, g0 * acc[ai][bj][m][0], g1 * acc[ai][bj][m][1]);
                    }
                }
    }
};
struct BranchOrder {
    pg8::StaticOrder base;
    __device__ __forceinline__ bool next(int r, pg8::Unit& u) const { pg8::Unit t; if (!base.next(r / 3, t)) return false; const int i = r % 3; u.pm = i * 64 + t.pm; u.pn = i * 4 + t.pn; return true; }
    __device__ __forceinline__ void a_ready(const pg8::Unit&) const {}
    __device__ __forceinline__ void done(const pg8::Unit&) const {}
};

struct Frame { unsigned char* lds; int tid, lane, wave, G, gw, ngw, bx; };
__device__ __forceinline__ void frame_refresh(Frame& F) { int t = threadIdx.x; asm volatile("" : "+v"(t)); int g = gridDim.x, bx = blockIdx.x; asm volatile("" : "+s"(g), "+s"(bx));
    F.tid = t; F.lane = t & 63; F.wave = __builtin_amdgcn_readfirstlane(t >> 6); F.G = g; F.bx = bx; F.gw = bx * NWV + F.wave; F.ngw = g * NWV; }

__device__ __forceinline__ int map_row(int mode, int n) {
    if (mode == 1) { const int up = n >= FF, j = up ? n - FF : n; return 256 * (j >> 7) + (up ? 128 : 0) + (j & 127); }
    if (mode == 2) { if (n >= 1024) return n; const int j = n & 511; return 256 * (j >> 7) + ((n >> 9) ? 128 : 0) + (j & 127); }
    return n;
}
__device__ __forceinline__ void cvt_weight(const Frame& F, const float* __restrict__ W, int K, int N, bf16* WT, int mode, const float* __restrict__ gk, int& base) {
    const int nblk = N / 64, nitems = (K / 64) * nblk, lane = F.lane, q = lane >> 4, c = lane & 15;
    int first = F.gw - (base % F.ngw); if (first < 0) first += F.ngw;
    base += nitems;
    for (int item = first; item < nitems; item += F.ngw) {
        const int kb = item / nblk, nb = item % nblk, k0 = 64 * kb + 16 * q, n0 = 64 * nb;
        const f32x4* src = (const f32x4*)(W + (size_t)k0 * N + n0 + 4 * c);
        f32x4 v[16];
#pragma unroll
        for (int i = 0; i < 16; ++i) v[i] = __builtin_nontemporal_load(src + (size_t)i * (N / 4));
        if (gk) {
            f32x4 g4[4];
#pragma unroll
            for (int i = 0; i < 4; ++i) g4[i] = *(const f32x4*)(gk + k0 + 4 * i);
#pragma unroll
            for (int i = 0; i < 16; ++i) v[i] = v[i] * g4[i >> 2][i & 3];
        }
        bf16* dst = WT + (size_t)(map_row(mode, n0) + 4 * c) * K + k0;
#pragma unroll
        for (int j = 0; j < 4; ++j) {
            u32x4 o0, o1;
            o0.x = pk2(v[0][j], v[1][j]); o0.y = pk2(v[2][j], v[3][j]); o0.z = pk2(v[4][j], v[5][j]); o0.w = pk2(v[6][j], v[7][j]);
            o1.x = pk2(v[8][j], v[9][j]); o1.y = pk2(v[10][j], v[11][j]); o1.z = pk2(v[12][j], v[13][j]); o1.w = pk2(v[14][j], v[15][j]);
            *(u32x4*)(dst + (size_t)j * K) = o0; *(u32x4*)(dst + (size_t)j * K + 8) = o1;
        }
    }
}
__device__ __forceinline__ void norm_rows(const Frame& F, const float* x, const float* __restrict__ g, bf16* xn) {
    f32x4 gv[4];
#pragma unroll
    for (int j = 0; j < 4; ++j) gv[j] = ((const f32x4*)g)[F.lane + 64 * j];
    for (int m = F.gw; m < TOK; m += F.ngw) {
        const f32x4* xr = (const f32x4*)(x + (size_t)m * DM) + F.lane; f32x4 v[4]; float s = 0.f;
#pragma unroll
        for (int j = 0; j < 4; ++j) { v[j] = xr[64 * j]; s += (v[j].x * v[j].x + v[j].y * v[j].y) + (v[j].z * v[j].z + v[j].w * v[j].w); }
        const float rs = 1.0f / sqrtf(wave_sum(s) * (1.f / DM) + EPS);
        u32x2* o = (u32x2*)(xn + (size_t)m * DM) + F.lane;
#pragma unroll
        for (int j = 0; j < 4; ++j) { const f32x4 y = v[j] * rs * gv[j]; u32x2 w; w.x = pk2(y.x, y.y); w.y = pk2(y.z, y.w); o[64 * j] = w; }
    }
}
__device__ __forceinline__ void prep_rows(const Frame& F, const float* x, bf16* xb, float* ss) {
    for (int m0 = F.gw; m0 < TOK; m0 += 2 * F.ngw) {
        f32x4 v[2][4];
#pragma unroll
        for (int r = 0; r < 2; ++r) { const int m = m0 + r * F.ngw; if (m < TOK) { const f32x4* xr = (const f32x4*)(x + (size_t)m * DM) + F.lane;
#pragma unroll
            for (int j = 0; j < 4; ++j) v[r][j] = __builtin_nontemporal_load(xr + 64 * j); } }
#pragma unroll
        for (int r = 0; r < 2; ++r) { const int m = m0 + r * F.ngw; if (m < TOK) { float s = 0.f;
#pragma unroll
            for (int j = 0; j < 4; ++j) s += (v[r][j].x * v[r][j].x + v[r][j].y * v[r][j].y) + (v[r][j].z * v[r][j].z + v[r][j].w * v[r][j].w);
            s = wave_sum(s);
            u32x2* o = (u32x2*)(xb + (size_t)m * DM) + F.lane;
#pragma unroll
            for (int j = 0; j < 4; ++j) { u32x2 w; w.x = pk2(v[r][j].x, v[r][j].y); w.y = pk2(v[r][j].z, v[r][j].w); o[64 * j] = w; }
            if (F.lane == 0) *(f32x4*)(ss + (size_t)m * 4) = (f32x4){s, 0.f, 0.f, 0.f}; } }
    }
}
__device__ __forceinline__ void final_norm_rows(const Frame& F, const bf16* xb, const float* ss, float* out, const float* __restrict__ g) {
    f32x4 gv[2][2];
#pragma unroll
    for (int j = 0; j < 2; ++j) { gv[j][0] = *(const f32x4*)(g + 512 * j + 8 * F.lane); gv[j][1] = *(const f32x4*)(g + 512 * j + 8 * F.lane + 4); }
    const int rbase = (F.bx & 7) * 2048 + (F.bx >> 3) * 8 + F.wave;
#pragma unroll 1
    for (int k0 = 0; k0 < 8; k0 += 4) {
        u32x4 raw[4][2]; float rs[4];
#pragma unroll
        for (int r = 0; r < 4; ++r) { const int m = rbase + 256 * (k0 + r);
#pragma unroll
            for (int j = 0; j < 2; ++j) raw[r][j] = *(const u32x4*)(xb + (size_t)m * DM + 512 * j + 8 * F.lane);
            rs[r] = row_rs(ss, m); }
#pragma unroll
        for (int r = 0; r < 4; ++r) { const int m = rbase + 256 * (k0 + r);
#pragma unroll
            for (int j = 0; j < 2; ++j) { f32x4 v0, v1; unpack8(raw[r][j], v0, v1);
                __builtin_nontemporal_store(v0 * rs[r] * gv[j][0], (f32x4*)(out + (size_t)m * DM + 512 * j + 8 * F.lane));
                __builtin_nontemporal_store(v1 * rs[r] * gv[j][1], (f32x4*)(out + (size_t)m * DM + 512 * j + 8 * F.lane + 4)); } }
    }
}
__device__ __forceinline__ void rope_tables(const Frame& F, float* rope) {
    const float invf[8] = {1.0f, 0.1939227432012558f, 0.03760603070259094f, 0.007292664609849453f, 0.0014142135623842478f, 0.00027424818836152554f, 5.318296098266728e-05f, 1.0313386155758053e-05f};
    for (int idx = blockIdx.x * NTHR + F.tid; idx < SEQ * 8; idx += F.G * NTHR) {
        const int pos = idx >> 3, i = idx & 7;
        float fi = invf[0];
#pragma unroll
        for (int k = 1; k < 8; ++k) fi = (i == k) ? invf[k] : fi;
        const float ang = (float)pos * fi;
        const double rev = (double)ang * 0.15915494309189535; const float fr = (float)(rev - __builtin_rint(rev));
        rope[idx] = __builtin_amdgcn_cosf(fr); rope[SEQ * 8 + idx] = __builtin_amdgcn_sinf(fr);
    }
}

struct MixP { const bf16 *GLU, *U, *SV, *K; bf16 *YA, *YB; float* KMEAN;
              const float *conv_w, *conv_b, *cln_g, *cln_b, *sln_g, *sln_b, *sgu_w, *sgu_b; };

__device__ __forceinline__ void conv_item(const Frame& F, const MixP& P, int ci, const int mode) {
    bf16* in_t = (bf16*)F.lds;
    float* out_t = (float*)(F.lds + 63488);
    const int t0 = ci * 32, tin = t0 & (SEQ - 1), tid = F.tid;
    const int cp = tid & 255, th = tid >> 8;
    f32x2 w2[31];
#pragma unroll
    for (int k = 0; k < 31; ++k) w2[k] = *(const f32x2*)(P.conv_w + k * CW + 2 * cp);
    const f32x2 bb = *(const f32x2*)(P.conv_b + 2 * cp);
    unsigned kv[16];
#pragma unroll
    for (int i = 0; i < 16; ++i) kv[i] = (mode != 2) ? *(const unsigned*)(P.K + (size_t)(t0 + th * 16 + i) * CW + 2 * cp) : 0u;
    if (mode == 1) { float k0 = 0.f, k1 = 0.f;
#pragma unroll
        for (int i = 0; i < 16; ++i) { k0 += bflo(kv[i]); k1 += bfhi(kv[i]); }
        *(f32x2*)(P.KMEAN + (size_t)(ci * 2 + th) * CW + 2 * cp) = (f32x2){k0, k1}; return; }
#pragma unroll 1
    for (int hb = 0; hb < 2; ++hb) {
        u32x4 tv[4];
#pragma unroll
        for (int p = 0; p < 4; ++p) { const int idx = tid + (hb * 4 + p) * NTHR, r = idx >> 6, ch = idx & 63; tv[p] = (u32x4){0u, 0u, 0u, 0u};
            if (idx < 62 * 64 && tin - 30 + r >= 0) tv[p] = *(const u32x4*)(P.GLU + arena_off(t0 - 30 + r) + ch * 8); }
#pragma unroll
        for (int p = 0; p < 4; ++p) { const int idx = tid + (hb * 4 + p) * NTHR, r = idx >> 6, ch = idx & 63; if (idx < 62 * 64) *(u32x4*)(in_t + r * CW + ch * 8) = tv[p]; }
    }
    if (mode != 2) { float k0 = 0.f, k1 = 0.f;
#pragma unroll
      for (int i = 0; i < 16; ++i) { k0 += bflo(kv[i]); k1 += bfhi(kv[i]); }
      *(f32x2*)(P.KMEAN + (size_t)(ci * 2 + th) * CW + 2 * cp) = (f32x2){k0, k1}; }
    __syncthreads();
    {
#pragma unroll 1
        for (int rd = 0; rd < 2; ++rd) {
            const int tb = th * 16 + rd * 8; f32x2 x2[38];
#pragma unroll
            for (int r = 0; r < 38; ++r) { const unsigned uv = *(const unsigned*)(in_t + (tb + r) * CW + 2 * cp); x2[r] = (f32x2){bflo(uv), bfhi(uv)}; }
#pragma unroll
            for (int t = 0; t < 8; ++t) { f32x2 a = bb;
#pragma unroll
                for (int k = 0; k < 31; ++k) a = w2[k] * x2[t + k] + a;
                *(f32x2*)(out_t + (tb + t) * CW + 2 * cp) = a; }
        }
    }
    __syncthreads();
    {
        const int lane = F.lane; f32x4 g0 = *(const f32x4*)(P.cln_g + lane * 8), g1 = *(const f32x4*)(P.cln_g + lane * 8 + 4), b0 = *(const f32x4*)(P.cln_b + lane * 8), b1 = *(const f32x4*)(P.cln_b + lane * 8 + 4);
#pragma unroll
        for (int i = 0; i < 4; ++i) { const int t = F.wave * 4 + i;
            f32x4 v0 = *(const f32x4*)(out_t + t * CW + lane * 8), v1 = *(const f32x4*)(out_t + t * CW + lane * 8 + 4);
            const float mean = wave_sum((v0.x + v0.y) + (v0.z + v0.w) + (v1.x + v1.y) + (v1.z + v1.w)) * (1.f / CW);
            v0 = v0 - mean; v1 = v1 - mean;
            const float var = wave_sum((v0.x * v0.x + v0.y * v0.y) + (v0.z * v0.z + v0.w * v0.w) + (v1.x * v1.x + v1.y * v1.y) + (v1.z * v1.z + v1.w * v1.w)) * (1.f / CW);
            const float rstd = 1.0f / sqrtf(var + EPS);
            f32x4 y0 = v0 * rstd * g0 + b0, y1 = v1 * rstd * g1 + b1;
#pragma unroll
            for (int e = 0; e < 4; ++e) { y0[e] = y0[e] * sigm(y0[e]); y1[e] = y1[e] * sigm(y1[e]); }
            store8(P.YA + (size_t)(t0 + t) * CW + lane * 8, y0, y1); }
    }
    __syncthreads();
}
__device__ __forceinline__ void sgu_item(const Frame& F, const MixP& P, int si) {
    const int chunk = si >> 1, gp = si & 1, tb = chunk * 128, lane = F.lane, wave = F.wave;
    bf16* vT = (bf16*)F.lds;
    const int t0 = wave * 16, fr = lane & 15, fq = lane >> 4, t = t0 + fr;
    {
        const f32x4 g0 = *(const f32x4*)(P.sln_g + lane * 8), g1 = *(const f32x4*)(P.sln_g + lane * 8 + 4), b0 = *(const f32x4*)(P.sln_b + lane * 8), b1 = *(const f32x4*)(P.sln_b + lane * 8 + 4);
        u32x4 raw[16];
#pragma unroll
        for (int i = 0; i < 16; ++i) raw[i] = *(const u32x4*)(P.SV + (size_t)(tb + wave * 16 + i) * CW + lane * 8);
#pragma unroll
        for (int i = 0; i < 16; ++i) { const int s = wave * 16 + i; f32x4 v0, v1; unpack8(raw[i], v0, v1);
            const float mean = wave_sum((v0.x + v0.y) + (v0.z + v0.w) + (v1.x + v1.y) + (v1.z + v1.w)) * (1.f / CW);
            v0 = v0 - mean; v1 = v1 - mean;
            const float var = wave_sum((v0.x * v0.x + v0.y * v0.y) + (v0.z * v0.z + v0.w * v0.w) + (v1.x * v1.x + v1.y * v1.y) + (v1.z * v1.z + v1.w * v1.w)) * (1.f / CW);
            const float rstd = 1.0f / sqrtf(var + EPS);
            const f32x4 y0 = v0 * rstd * g0 + b0, y1 = v1 * rstd * g1 + b1;
            if ((lane >> 5) == gp) { bf16* d = vT + (((lane >> 4) & 1) * 128 + (lane & 15) * 8) * 136 + s;
#pragma unroll
                for (int e = 0; e < 4; ++e) { d[e * 136] = (bf16)(pk2(y0[e], 0.f) & 0xffffu); d[(4 + e) * 136] = (bf16)(pk2(y1[e], 0.f) & 0xffffu); } } }
    }
    __syncthreads();
#pragma unroll 1
    for (int gi = 0; gi < 2; ++gi) {
        const int g = gp * 2 + gi; const bf16* vTg = vT + gi * 128 * 136;
        const float* Wrow = P.sgu_w + ((size_t)g * 128 + t) * 128;
        f32x4 wa[4], wb[4];
#pragma unroll
        for (int ks = 0; ks < 4; ++ks) { wa[ks] = (f32x4){0.f, 0.f, 0.f, 0.f}; wb[ks] = wa[ks]; if (32 * ks < t0 + 16) { wa[ks] = *(const f32x4*)(Wrow + 32 * ks + 8 * fq); wb[ks] = *(const f32x4*)(Wrow + 32 * ks + 8 * fq + 4); } }
        u32x2 ur[8];
#pragma unroll
        for (int cb = 0; cb < 8; ++cb) ur[cb] = *(const u32x2*)(P.U + arena_off(tb + t) + g * 128 + 16 * cb + 4 * fq);
        const float bs = P.sgu_b[g * 128 + t];
        f32x4 acc[8];
#pragma unroll
        for (int cb = 0; cb < 8; ++cb) acc[cb] = (f32x4){0.f, 0.f, 0.f, 0.f};
#pragma unroll
        for (int ks = 0; ks < 4; ++ks) if (32 * ks < t0 + 16) { const int sb = 32 * ks + 8 * fq;
            float wv[8] = {wa[ks].x, wa[ks].y, wa[ks].z, wa[ks].w, wb[ks].x, wb[ks].y, wb[ks].z, wb[ks].w};
#pragma unroll
            for (int e = 0; e < 8; ++e) wv[e] = (sb + e <= t) ? wv[e] : 0.f;
            u32x4 wp; wp.x = pk2(wv[0], wv[1]); wp.y = pk2(wv[2], wv[3]); wp.z = pk2(wv[4], wv[5]); wp.w = pk2(wv[6], wv[7]);
            const bf16x8 wf = __builtin_bit_cast(bf16x8, wp);
#pragma unroll
            for (int cb = 0; cb < 8; ++cb) { const bf16x8 vf = *(const bf16x8*)(vTg + (16 * cb + fr) * 136 + sb); acc[cb] = __builtin_amdgcn_mfma_f32_16x16x32_bf16(vf, wf, acc[cb], 0, 0, 0); } }
#pragma unroll
        for (int cb = 0; cb < 8; ++cb) { const size_t off = (size_t)(tb + t) * CW + g * 128 + 16 * cb + 4 * fq;
            u32x2 o; o.x = pk2(bflo(ur[cb].x) * (acc[cb][0] + bs), bfhi(ur[cb].x) * (acc[cb][1] + bs)); o.y = pk2(bflo(ur[cb].y) * (acc[cb][2] + bs), bfhi(ur[cb].y) * (acc[cb][3] + bs));
            *(u32x2*)(P.YB + off) = o; }
    }
    __syncthreads();
}
__device__ __forceinline__ bool mix_deferred(int bx) { return (bx >> 3) == 0 && ((bx & 7) & 3) != 0; }
__device__ __forceinline__ void mix_phase(const Frame& F, const MixP& P) {
    const int cls = F.bx & 7, rank = F.bx >> 3;
    if (mix_deferred(F.bx)) conv_item(F, P, 64 * cls + rank, 1); else conv_item(F, P, 64 * cls + rank, 0);
    conv_item(F, P, 64 * cls + 32 + rank, 0);
    sgu_item(F, P, 32 * cls + rank);
}
}

#ifndef PHM
#define PHM 0xFFFF
#endif
#ifndef REP_SYNC
#define REP_SYNC 1
#endif
#ifndef REP_NORM
#define REP_NORM 1
#endif
#ifndef REP_MIX
#define REP_MIX 1
#endif
#ifndef REP_WI
#define REP_WI 1
#endif
#ifndef REP_WO
#define REP_WO 1
#endif
#ifndef REP_WIN
#define REP_WIN 1
#endif
#ifndef REP_BR
#define REP_BR 1
#endif
#ifndef REP_CVT
#define REP_CVT 1
#endif
#ifndef REP_ATT
#define REP_ATT 1
#endif
#define GSYNC() do { _Pragma("unroll 1") for (int rs_ = 0; rs_ < REP_SYNC; ++rs_) xb::xcd_barrier(xbar); } while (0)
#define LSYNC() do { if (local_ok) xb::xcd_barrier_local(xbar); else xb::xcd_barrier(xbar); } while (0)
struct Args { const float* in[21]; float* out; unsigned char* ws; };
typedef __attribute__((address_space(4))) const unsigned char* kargp_t;
__device__ __forceinline__ const float* ldarg(int i) {
#if defined(__HIP_DEVICE_COMPILE__)
    kargp_t p = (kargp_t)__builtin_amdgcn_kernarg_segment_ptr(); asm volatile("" : "+s"(p)); return (const float*)*(__attribute__((address_space(4))) const unsigned long long*)(p + 8 * i);
#else
    return nullptr;
#endif
}
#define INP(i) ldarg(i)
#define TAIL_FRAME(FT, ntiles) mk::Frame FT = F; const int R_ = (ntiles) % F.G; const bool tail_idle_ = R_ > 0 && F.bx >= R_; FT.gw = (F.bx - R_) * mk::NWV + F.wave; FT.ngw = (F.G - R_) * mk::NWV;
template <class Sched> __device__ __forceinline__ void preload_rs(const Sched& S, const float* SS, float* rsl) {
    int t = threadIdx.x; asm volatile("" : "+v"(t)); pg8::Unit u;
    for (int i = 0; i < 8 && S.next(i, u); ++i) if (t < 256) rsl[i * 256 + t] = mk::row_rs(SS, u.pm * 256 + t);
    __syncthreads();
}
template <class Sched> __device__ __forceinline__ void preload_gb(const Sched& S, const float* gate_b, float* gbl) {
    int t = threadIdx.x; asm volatile("" : "+v"(t)); pg8::Unit u;
    for (int i = 0; i < 8 && S.next(i, u); ++i) if (t < 256 && u.pn >= 14) gbl[i * 256 + t] = gate_b[(u.pn - 14) * 256 + t];
}
#define OUTP() ((float*)ldarg(21))
#define WSB(off) ((mk::bf16*)((unsigned char*)ldarg(22) + (off)))
#define WSF(off) ((float*)((unsigned char*)ldarg(22) + (off)))
#define OB(off) ((mk::bf16*)((unsigned char*)ldarg(21) + (off)))
__global__ void __launch_bounds__(512, 2) mk_fwd(Args a) {
    using namespace mk;
    extern __shared__ __attribute__((aligned(16))) unsigned char lds[];
    cg::grid_group grid = cg::this_grid();
    Frame F; F.lds = lds; F.tid = threadIdx.x; F.lane = F.tid & 63; F.wave = __builtin_amdgcn_readfirstlane(F.tid >> 6); F.G = gridDim.x;
    F.gw = blockIdx.x * NWV + F.wave; F.ngw = F.G * NWV;
    PG8_LAS unsigned char* ldsA = (PG8_LAS unsigned char*)lds;
    if (F.tid < 32) ((PG8_LAS unsigned*)(ldsA + 131072))[F.tid] = 0u;
    __syncthreads();
    if (blockIdx.x == 0) {
        unsigned* w0 = (unsigned*)ldarg(22);
        for (int i = F.tid; i < 16384; i += NTHR) __hip_atomic_store(w0 + i, 0u, __ATOMIC_RELAXED, __HIP_MEMORY_SCOPE_AGENT);
        asm volatile("s_waitcnt vmcnt(0)" ::: "memory"); __threadfence();
    }
    grid.sync();
    const xb::XcdBarrier xbar = xb::xcd_barrier_post((unsigned*)ldarg(22) + 1024, (volatile PG8_LAS unsigned*)(ldsA + 131072) + 8);
    xb::xcd_local_post(xbar);

    { int cb_ = 0;
      cvt_weight(F, INP(2), DM, 2 * FF, WSB(WS_FALT_WI), 1, INP(1), cb_);
      cvt_weight(F, INP(3), FF, DM, WSB(WS_FALT_WO), 0, nullptr, cb_);
      cvt_weight(F, INP(5), DM, NIN, WSB(WS_WIN), 2, INP(4), cb_); }
    prep_rows(F, INP(0), WSB(WS_XN), WSF(WS_SS));
    GSYNC();
    const bool local_ok = xb::xcd_local_ok(xbar);
#pragma unroll 1
    for (int l = 0; l < NLAYER; ++l) {
#pragma unroll 1
        for (int f = 0; f < 2; ++f) {
            const bool first = (l == 0 && f == 0);
#pragma unroll 1
            for (int rw_ = 0; rw_ < REP_WI; ++rw_)
            { frame_refresh(F); pg8::Gemm g{WSB(WS_XN), WSB(f ? WS_WFI : WS_FALT_WI), TOK, 2 * FF, DM}; pg8::StaticOrder S; S.init(TOK, 2 * FF, F.G, F.bx); EpiSwiGLU E{(unsigned char*)ldarg(22), (const PG8_LAS float*)(ldsA + LDS_RS), 0}; preload_rs(S, WSF(WS_SS), (float*)(lds + LDS_RS));
              pg8::gemm_phase<EpiSwiGLU, pg8::StaticOrder, true, true>(ldsA, g, S, E); }
            { TAIL_FRAME(FT, (TOK / 256) * (2 * FF / 256))
              if (tail_idle_) { int cb_ = 0;
                  if (f == 0) cvt_weight(FT, INP(18) + (size_t)l * DM * 2 * FF, DM, 2 * FF, WSB(WS_WFI), 1, INP(17) + l * DM, cb_);
                  else if (l + 1 < NLAYER) cvt_weight(FT, INP(2) + (size_t)(l + 1) * DM * 2 * FF, DM, 2 * FF, WSB(WS_FALT_WI), 1, INP(1) + (l + 1) * DM, cb_); } }
            LSYNC();
            frame_refresh(F);
            { pg8::Gemm g{WSB(WS_ACT), WSB(f ? WS_WFO : WS_FALT_WO), TOK, DM, FF}; pg8::StaticOrder S; S.init(TOK, DM, F.G, F.bx);
              EpiResid E{0.5f, (unsigned char*)ldarg(22)};
              pg8::gemm_phase<EpiResid, pg8::StaticOrder, false, true>(ldsA, g, S, E); }
            if (f == 0) LSYNC(); else GSYNC();
            if (f == 0) {
#pragma unroll 1
                for (int ri_ = 0; ri_ < REP_WIN; ++ri_)
                frame_refresh(F);
                { pg8::Gemm g{WSB(WS_XN), WSB(WS_WIN), TOK, NIN, DM}; pg8::StaticOrder S; S.init(TOK, NIN, F.G, F.bx);
                  EpiWin E{(unsigned char*)ldarg(22), INP(15) + l * 3 * DM, (const PG8_LAS float*)(ldsA + LDS_RS), 0, (unsigned char*)ldarg(21)}; preload_gb(S, INP(15) + l * 3 * DM, (float*)(lds + LDS_GB)); preload_rs(S, WSF(WS_SS), (float*)(lds + LDS_RS));
                  pg8::gemm_phase<EpiWin, pg8::StaticOrder, true, true>(ldsA, g, S, E); }
                { TAIL_FRAME(FT, (TOK / 256) * (NIN / 256))
                  if (tail_idle_) { int cb_ = 0;
                      cvt_weight(FT, INP(19) + (size_t)l * FF * DM, FF, DM, WSB(WS_WFO), 0, nullptr, cb_);
#pragma unroll 1
                      for (int i = 0; i < 3; ++i) cvt_weight(FT, INP(14) + ((size_t)l * 3 + i) * CW * DM, CW, DM, WSB(WS_WBR) + (size_t)i * DM * CW, 0, nullptr, cb_);
                      cvt_weight(FT, INP(16) + (size_t)l * DM * DM, DM, DM, WSB(WS_WOUT), 0, nullptr, cb_); } }
                LSYNC();
#pragma unroll 1
                for (int rm_ = 0; rm_ < REP_MIX; ++rm_) {
                frame_refresh(F);
                { MixP P{WSB(WS_GLU), WSB(WS_U), OB(48 * mk::MiB), WSB(WS_K), OB(0), OB(16 * mk::MiB), WSF(WS_KMEAN), INP(6) + l * 31 * CW, INP(7) + l * CW, INP(8) + l * CW, INP(9) + l * CW, INP(10) + l * CW, INP(11) + l * CW, INP(12) + (size_t)l * 4 * 128 * 128, INP(13) + l * 4 * 128};
                  mix_phase(F, P); } }
                GSYNC();
                frame_refresh(F);
                if (l + 1 < NLAYER) {
                    int cb_ = 0;
                    cvt_weight(F, INP(3) + (size_t)(l + 1) * FF * DM, FF, DM, WSB(WS_FALT_WO), 0, nullptr, cb_);
                    cvt_weight(F, INP(5) + (size_t)(l + 1) * DM * NIN, DM, NIN, WSB(WS_WIN), 2, INP(4) + (l + 1) * DM, cb_);
                }
                if (mix_deferred(F.bx)) { MixP P{WSB(WS_GLU), WSB(WS_U), OB(48 * mk::MiB), WSB(WS_K), OB(0), OB(16 * mk::MiB), WSF(WS_KMEAN), INP(6) + l * 31 * CW, INP(7) + l * CW, INP(8) + l * CW, INP(9) + l * CW, INP(10) + l * CW, INP(11) + l * CW, INP(12) + (size_t)l * 4 * 128 * 128, INP(13) + l * 4 * 128};
                    conv_item(F, P, 64 * (F.bx & 7), 2); }
                __syncthreads();
                { const attn_body::AttnTensors AT{(const attn_body::bf16*)OB(32 * mk::MiB), (const attn_body::bf16*)WSB(WS_K), (const attn_body::bf16*)WSB(WS_V), (attn_body::bf16*)OB(32 * mk::MiB), WSF(WS_KMEAN)};
                  const attn_body::StaticOrder S((int)F.G, F.bx);
                  attn_body::attn_phase<attn_body::StaticOrder>((char*)lds, AT, S); }
                GSYNC();
                frame_refresh(F);
                { pg8::Gemm g{OB(0), WSB(WS_WBR), 3 * TOK, 3 * DM, CW}; BranchOrder S; S.base.init(TOK, DM, F.G, F.bx); EpiBranch E{(const unsigned char*)WSB(WS_GATES), WSB(WS_MERGED)};
                  pg8::gemm_phase<EpiBranch, BranchOrder, true, true>(ldsA, g, S, E); }
                LSYNC();
                frame_refresh(F);
                { pg8::Gemm g{WSB(WS_MERGED), WSB(WS_WOUT), TOK, DM, DM}; pg8::StaticOrder S; S.init(TOK, DM, F.G, F.bx);
                  EpiResid E{1.0f, (unsigned char*)ldarg(22)};
                  pg8::gemm_phase<EpiResid, pg8::StaticOrder, false, true>(ldsA, g, S, E); }
                LSYNC();
            }
        }
    }
    frame_refresh(F);
    final_norm_rows(F, WSB(WS_XN), WSF(WS_SS), OUTP(), INP(20));
}

extern "C" void kernel_launch(void* const* d_in, const int* in_sizes, int n_in, void* d_out, int out_size, void* d_ws, size_t ws_size, hipStream_t stream) {
    static int grid = 0;
    if (grid == 0) {
        if (n_in != 21 || out_size != mk::TOK * mk::DM || ws_size < mk::WS_END) { fprintf(stderr, "kernel_launch: unexpected shapes (n_in %d out %d ws %zu)\n", n_in, out_size, ws_size); grid = -1; return; }
        int dev = 0, cus = 0, per_cu = 0;
        hipGetDevice(&dev); hipDeviceGetAttribute(&cus, hipDeviceAttributeMultiprocessorCount, dev);
        if (hipFuncSetAttribute((const void*)mk_fwd, hipFuncAttributeMaxDynamicSharedMemorySize, mk::LDS_BYTES) != hipSuccess) { fprintf(stderr, "kernel_launch: hipFuncSetAttribute failed\n"); grid = -1; return; }
        if (hipOccupancyMaxActiveBlocksPerMultiprocessor(&per_cu, (const void*)mk_fwd, mk::NTHR, mk::LDS_BYTES) != hipSuccess || per_cu < 1) { fprintf(stderr, "kernel_launch: occupancy query failed (%d)\n", per_cu); grid = -1; return; }
        grid = cus * (per_cu > 1 ? 1 : per_cu);
        if (grid != 256) { fprintf(stderr, "kernel_launch: built for a 256-CU device (grid %d)\n", grid); grid = -1; return; }
    }
    if (grid < 0) return;
    Args a{};
    for (int i = 0; i < 21; ++i) a.in[i] = (const float*)d_in[i];
    a.out = (float*)d_out; a.ws = (unsigned char*)d_ws;
    void* args[] = {&a};
    hipError_t e = hipLaunchCooperativeKernel((const void*)mk_fwd, dim3(grid), dim3(mk::NTHR), args, mk::LDS_BYTES, stream);
    if (e != hipSuccess) fprintf(stderr, "cooperative launch failed: %s (grid %d)\n", hipGetErrorString(e), grid);
}
```
